# Optimizing an MI355X kernel written in HIP

```python
import math
import jax, jax.numpy as jnp
from jax import lax
import numpy as np

D_MODEL = 1024
BATCH = 32
SEQ = 256
DEPTH = 4
DEC_BATCH = 2
DEC_SEQ = 2048
PAST_LEN = 512

GRID_W = 64
HEAD_DIM = 64
N_HEADS_A = 8
N_KV_A = 2
N_HEADS_B = 8
N_KV_B = 2
A_WIDTH = N_HEADS_A * HEAD_DIM
B_WIDTH = N_HEADS_B * HEAD_DIM
KV_WIDTH_A = N_KV_A * HEAD_DIM
KV_WIDTH_B = N_KV_B * HEAD_DIM
C_WIDTH = 512
C_GROUPS = 4
C_GROUP_DIM = C_WIDTH // C_GROUPS
CHUNK = 128
BLOCK = 128
WINDOW = 128
N_BRANCH = 3
IN_WIDTH = 2 * A_WIDTH + 2 * KV_WIDTH_A + 2 * B_WIDTH + 2 * KV_WIDTH_B + 3 * C_WIDTH
ROPE_BASE = 10000.0
ROPE_FREQS = HEAD_DIM // 4
EPS = 1e-6
NEG_INF = -1e30
DEEPNORM_ALPHA = (2 * DEPTH) ** 0.25
DEEPNORM_BETA = (8 * DEPTH) ** -0.25

kernel_name = 'hybrid_flow_prefix_trunk_step'


def layer_norm(x, g=None, b=None):
    xf = x.astype(jnp.float32)
    mu = jnp.mean(xf, axis=-1, keepdims=True)
    var = jnp.mean(jnp.square(xf - mu), axis=-1, keepdims=True)
    y = (xf - mu) * lax.rsqrt(var + EPS)
    if g is not None:
        y = y * g.astype(jnp.float32) + b.astype(jnp.float32)
    return y.astype(x.dtype)


def rms_norm(x, g):
    xf = x.astype(jnp.float32)
    y = xf * lax.rsqrt(jnp.mean(jnp.square(xf), axis=-1, keepdims=True) + EPS) * g.astype(jnp.float32)
    return y.astype(x.dtype)


def axial_rope_tables(n_tokens):
    rows = n_tokens // GRID_W
    row = jnp.repeat(jnp.arange(rows, dtype=jnp.float32), GRID_W)
    col = jnp.tile(jnp.arange(GRID_W, dtype=jnp.float32), rows)
    inv_freq = jnp.power(ROPE_BASE, -jnp.arange(ROPE_FREQS, dtype=jnp.float32) / ROPE_FREQS)
    ang = jnp.concatenate([row[:, None] * inv_freq, col[:, None] * inv_freq], axis=-1)
    return jnp.cos(ang), jnp.sin(ang)


def apply_rope(x, cos, sin):
    half = HEAD_DIM // 2
    xf = x.astype(jnp.float32)
    x1, x2 = xf[..., :half], xf[..., half:]
    c = cos[None, :, None, :]
    s = sin[None, :, None, :]
    return jnp.concatenate([x1 * c - x2 * s, x2 * c + x1 * s], axis=-1).astype(x.dtype)


def ada_modulation(cvec, w_mod, b_mod):
    m = (jax.nn.silu(cvec) @ w_mod + b_mod)[..., None, :]
    shift, scale, gate = jnp.split(m, 3, axis=-1)
    return shift, scale, gate


def split_projection(p):
    B, T, _ = p.shape
    sizes = [A_WIDTH, KV_WIDTH_A, KV_WIDTH_A, A_WIDTH,
             B_WIDTH, KV_WIDTH_B, KV_WIDTH_B, B_WIDTH,
             C_WIDTH, C_WIDTH, C_WIDTH]
    qa, ka, va, ga, qb, kb, vb, gb, uc, vc, gc = jnp.split(p, np.cumsum(sizes)[:-1].tolist(), axis=-1)
    heads = lambda t, n: t.reshape(B, T, n, HEAD_DIM)
    return dict(qa=heads(qa, N_HEADS_A), ka=heads(ka, N_KV_A), va=heads(va, N_KV_A), ga=ga,
                qb=heads(qb, N_HEADS_B), kb=heads(kb, N_KV_B), vb=heads(vb, N_KV_B), gb=gb,
                uc=uc, vc=vc, gc=gc)


def dense_gqa(q, k, v, n_kv, sink=None):
    B, T, H, d = q.shape
    G = H // n_kv
    nb = T // BLOCK
    qb = (q * d ** -0.5).reshape(B, nb, BLOCK, n_kv, G, d).transpose(1, 0, 2, 3, 4, 5)

    def one_block(qblk):
        s = jnp.einsum('bqkgd,blkd->bkgql', qblk, k).astype(jnp.float32)
        if sink is not None:
            col = jnp.broadcast_to(sink.astype(jnp.float32).reshape(n_kv, G)[:, :, None, None], s.shape[:-1] + (1,))
            s = jnp.concatenate([s, col], axis=-1)
        p = jax.nn.softmax(s, axis=-1)
        if sink is not None:
            p = p[..., :-1]
        return jnp.einsum('bkgql,blkd->bqkgd', p.astype(v.dtype), v)

    o = lax.map(one_block, qb)
    return o.transpose(1, 0, 2, 3, 4, 5).reshape(B, T, H, d)


def window_gqa(q, k, v, k_ctx, v_ctx, sink):
    B, N, H, d = q.shape
    G = H // N_KV_B
    nb = N // BLOCK
    P = k_ctx.shape[1]
    qb = (q * d ** -0.5).reshape(B, nb, BLOCK, N_KV_B, G, d)
    pad = ((0, 0), (WINDOW, WINDOW), (0, 0), (0, 0))

    def bands(t):
        tp = jnp.pad(t, pad).reshape(B, nb + 2, BLOCK, N_KV_B, d)
        return jnp.concatenate([tp[:, :-2], tp[:, 1:-1], tp[:, 2:]], axis=2)

    kband, vband = bands(k), bands(v)
    nband = 3 * BLOCK
    s_band = jnp.einsum('bnqkgd,bnlkd->bnkgql', qb, kband).astype(jnp.float32)
    blk = jnp.arange(nb)[:, None, None] * BLOCK
    q_pos = blk + jnp.arange(BLOCK)[None, :, None]
    k_pos = blk - WINDOW + jnp.arange(nband)[None, None, :]
    valid = (jnp.abs(q_pos - k_pos) <= WINDOW) & (k_pos >= 0) & (k_pos < N)
    s_band = jnp.where(valid[None, :, None, None], s_band, NEG_INF)
    s_ctx = jnp.einsum('bnqkgd,blkd->bnkgql', qb, k_ctx).astype(jnp.float32)
    s_sink = jnp.broadcast_to(sink.astype(jnp.float32).reshape(N_KV_B, G)[:, :, None, None], s_ctx.shape[:-1] + (1,))
    p = jax.nn.softmax(jnp.concatenate([s_band, s_ctx, s_sink], axis=-1), axis=-1)
    p_band = p[..., :nband].astype(v.dtype)
    p_ctx = p[..., nband:nband + P].astype(v.dtype)
    o = (jnp.einsum('bnkgql,bnlkd->bnqkgd', p_band, vband)
         + jnp.einsum('bnkgql,blkd->bnqkgd', p_ctx, v_ctx))
    return o.reshape(B, N, H, d)


def chunk_sgu(u, v, g, b, w_s, b_s):
    B, T, _ = v.shape
    vn = layer_norm(v, g, b).reshape(B, T // CHUNK, CHUNK, C_GROUPS, C_GROUP_DIM)
    mixed = jnp.einsum('gpq,bnqgc->bnpgc', w_s, vn) + b_s.T[:, :, None]
    return u * mixed.reshape(B, T, C_WIDTH)


def merge_and_residual(x, h, gate, br, a_out, b_out, c_out, lw):
    B, T, _ = x.shape
    ya = (a_out.reshape(B, T, A_WIDTH) * jax.nn.silu(br['ga'])) @ lw['w_proj_a']
    yb = (b_out.reshape(B, T, B_WIDTH) * jax.nn.silu(br['gb'])) @ lw['w_proj_b']
    yc = (c_out * jax.nn.silu(br['gc'])) @ lw['w_proj_c']
    g_a, g_b, g_c = jnp.split(jax.nn.sigmoid(h @ lw['w_gate'] + lw['b_gate']), N_BRANCH, axis=-1)
    y = (g_a * ya + g_b * yb + g_c * yc) @ lw['w_out']
    return layer_norm(DEEPNORM_ALPHA * x + gate * y, lw['ln_g'], lw['ln_b'])


def context_layer(x, c_ctx, lw):
    shift, scale, gate = ada_modulation(c_ctx, lw['w_mod'], lw['b_mod'])
    h = layer_norm(x) * (1 + scale) + shift
    br = split_projection(h @ lw['w_in'])
    qa = rms_norm(br['qa'], lw['q_norm'])
    ka = rms_norm(br['ka'], lw['k_norm'])
    a_out = dense_gqa(qa, ka, br['va'], N_KV_A)
    b_out = dense_gqa(br['qb'], br['kb'], br['vb'], N_KV_B, lw['sink'])
    c_out = chunk_sgu(br['uc'], br['vc'], lw['sgu_g'], lw['sgu_b'], lw['w_spatial'], lw['b_spatial'])
    x_new = merge_and_residual(x, h, gate, br, a_out, b_out, c_out, lw)
    return x_new, ka, br['va'], br['kb'], br['vb']


def latent_layer(x, c, lw, ka_ctx, va_ctx, kb_ctx, vb_ctx, cos, sin):
    shift, scale, gate = ada_modulation(c, lw['w_mod'], lw['b_mod'])
    h = layer_norm(x) * (1 + scale) + shift
    br = split_projection(h @ lw['w_in'])
    qa = apply_rope(rms_norm(br['qa'], lw['q_norm']), cos, sin)
    ka = apply_rope(rms_norm(br['ka'], lw['k_norm']), cos, sin)
    a_out = dense_gqa(qa, jnp.concatenate([ka, ka_ctx], axis=1),
                      jnp.concatenate([br['va'], va_ctx], axis=1), N_KV_A)
    qb = apply_rope(br['qb'], cos, sin)
    kb = apply_rope(br['kb'], cos, sin)
    b_out = window_gqa(qb, kb, br['vb'], kb_ctx, vb_ctx, lw['sink'])
    c_out = chunk_sgu(br['uc'], br['vc'], lw['sgu_g'], lw['sgu_b'], lw['w_spatial'], lw['b_spatial'])
    return merge_and_residual(x, h, gate, br, a_out, b_out, c_out, lw)


def setup_inputs(seed: int = 0) -> dict:
    key = jax.random.key(seed)
    ks = jax.random.split(key, 32)
    nrm = lambda k, shape, s: jax.random.normal(k, shape, jnp.float32) * s
    D = D_MODEL
    cache_shape = (DEC_BATCH, DEPTH, PAST_LEN, N_KV_A, HEAD_DIM)
    return {
        'x_prompt': nrm(ks[0], (BATCH, SEQ, D), 1.0),
        'x_sample': nrm(ks[1], (DEC_BATCH, DEC_SEQ, D), 1.0),
        'cache_a_k': nrm(ks[2], cache_shape, 1.0),
        'cache_a_v': nrm(ks[3], cache_shape, 1.0),
        'cache_b_k': nrm(ks[4], (DEC_BATCH, DEPTH, PAST_LEN, N_KV_B, HEAD_DIM), 1.0),
        'cache_b_v': nrm(ks[5], (DEC_BATCH, DEPTH, PAST_LEN, N_KV_B, HEAD_DIM), 1.0),
        'c': nrm(ks[6], (DEC_BATCH, D), 1.0),
        'c_ctx': nrm(ks[7], (D,), 1.0),
        'w_mod': nrm(ks[8], (DEPTH, D, 3 * D), D ** -0.5),
        'b_mod': nrm(ks[9], (DEPTH, 3 * D), 0.02),
        'w_in': nrm(ks[10], (DEPTH, D, IN_WIDTH), D ** -0.5),
        'q_norm': 1.0 + nrm(ks[11], (DEPTH, HEAD_DIM), 0.02),
        'k_norm': 1.0 + nrm(ks[12], (DEPTH, HEAD_DIM), 0.02),
        'sink': nrm(ks[13], (DEPTH, N_HEADS_B), 0.5),
        'sgu_g': 1.0 + nrm(ks[14], (DEPTH, C_WIDTH), 0.02),
        'sgu_b': nrm(ks[15], (DEPTH, C_WIDTH), 0.02),
        'w_spatial': nrm(ks[16], (DEPTH, C_GROUPS, CHUNK, CHUNK), CHUNK ** -0.5),
        'b_spatial': nrm(ks[17], (DEPTH, C_GROUPS, CHUNK), 0.02),
        'w_proj_a': nrm(ks[18], (DEPTH, A_WIDTH, D), A_WIDTH ** -0.5 * DEEPNORM_BETA),
        'w_proj_b': nrm(ks[19], (DEPTH, B_WIDTH, D), B_WIDTH ** -0.5 * DEEPNORM_BETA),
        'w_proj_c': nrm(ks[20], (DEPTH, C_WIDTH, D), C_WIDTH ** -0.5 * DEEPNORM_BETA),
        'w_gate': nrm(ks[21], (DEPTH, D, N_BRANCH * D), D ** -0.5),
        'b_gate': nrm(ks[22], (DEPTH, N_BRANCH * D), 0.02),
        'w_out': nrm(ks[23], (DEPTH, D, D), D ** -0.5 * DEEPNORM_BETA),
        'ln_g': 1.0 + nrm(ks[24], (DEPTH, D), 0.02),
        'ln_b': nrm(ks[25], (DEPTH, D), 0.02),
    }


def reference(x_prompt, x_sample, cache_a_k, cache_a_v, cache_b_k, cache_b_v, c, c_ctx,
              w_mod, b_mod, w_in, q_norm, k_norm, sink, sgu_g, sgu_b, w_spatial, b_spatial,
              w_proj_a, w_proj_b, w_proj_c, w_gate, b_gate, w_out, ln_g, ln_b):
    cos, sin = axial_rope_tables(x_sample.shape[1])
    xp, xs = x_prompt, x_sample
    ka_l, va_l, kb_l, vb_l = [], [], [], []
    for l in range(DEPTH):
        lw = dict(w_mod=w_mod[l], b_mod=b_mod[l], w_in=w_in[l], q_norm=q_norm[l], k_norm=k_norm[l],
                  sink=sink[l], sgu_g=sgu_g[l], sgu_b=sgu_b[l], w_spatial=w_spatial[l],
                  b_spatial=b_spatial[l], w_proj_a=w_proj_a[l], w_proj_b=w_proj_b[l],
                  w_proj_c=w_proj_c[l], w_gate=w_gate[l], b_gate=b_gate[l], w_out=w_out[l],
                  ln_g=ln_g[l], ln_b=ln_b[l])
        xp, ka, va, kb, vb = context_layer(xp, c_ctx, lw)
        ka_l.append(ka)
        va_l.append(va)
        kb_l.append(kb)
        vb_l.append(vb)
        xs = latent_layer(xs, c, lw, cache_a_k[:, l], cache_a_v[:, l], cache_b_k[:, l], cache_b_v[:, l], cos, sin)
    state_a_k = jnp.stack(ka_l, axis=1)
    state_a_v = jnp.stack(va_l, axis=1)
    state_b_k = jnp.stack(kb_l, axis=1)
    state_b_v = jnp.stack(vb_l, axis=1)
    return (xp, xs, state_a_k, state_a_v, state_b_k, state_b_v)
```

```cpp
#include <hip/hip_runtime.h>
#include <hip/hip_cooperative_groups.h>
#include <cstdio>
#include <cstdint>
namespace cg = cooperative_groups;

#ifndef COOP
#define COOP 1
#endif

typedef unsigned short u16;
using bf16x8 = __attribute__((ext_vector_type(8))) short;
using s16x4 = __attribute__((ext_vector_type(4))) short;
using f32x16 = __attribute__((ext_vector_type(16))) float;
using f32x4 = __attribute__((ext_vector_type(4))) float;
typedef float f32x4_t __attribute__((ext_vector_type(4)));
typedef short v4i16_t __attribute__((ext_vector_type(4)));
typedef __attribute__((address_space(3))) const char* lds_cptr;

#define MFMA(a, b, c) __builtin_amdgcn_mfma_f32_32x32x16_bf16(a, b, c, 0, 0, 0)

constexpr int NTOK = 12288, NCTX = 8192;
constexpr int NTHR = 512, NWAVE = 8;
constexpr int LDP = 4096 + 128;
constexpr int LDS_BYTES = 131072 + 64;
constexpr int LDS_ITEM = 131072;
constexpr float ALPHA = 1.681792830507429f;
constexpr float LN_EPS = 1e-6f;

struct Params {
  const float* x_prompt; const float* x_sample; const float* cache0; const float* cache1; const float* cache2; const float* cache3; const float* c; const float* c_ctx;
  const float* w_mod; const float* b_mod; const float* w_in; const float* q_norm; const float* k_norm; const float* sink;
  const float* sgu_g; const float* sgu_b; const float* w_spatial; const float* b_spatial;
  const float* w_proj0; const float* w_proj1; const float* w_proj2; const float* w_gate; const float* b_gate; const float* w_out; const float* ln_g; const float* ln_b;
  float* out;
  float* mod; float* rope; unsigned* bar; int* cnt; u16* wsp; u16* cachebf; u16* wt_ig; u16* wt_p; u16* wt_o; u16* H; u16* P; u16* G;
};

__device__ __forceinline__ unsigned cvtpk(float lo, float hi) { unsigned r; asm("v_cvt_pk_bf16_f32 %0, %1, %2" : "=v"(r) : "v"(lo), "v"(hi)); return r; }
__device__ __forceinline__ float bflo(unsigned u) { return __uint_as_float(u << 16); }
__device__ __forceinline__ float bfhi(unsigned u) { return __uint_as_float(u & 0xffff0000u); }
__device__ __forceinline__ int crow(int r, int hi) { return (r & 3) + 8 * (r >> 2) + 4 * hi; }
__device__ __forceinline__ float silu_f(float x) { return x * __builtin_amdgcn_rcpf(1.f + __builtin_amdgcn_exp2f(-1.4426950408889634f * x)); }
__device__ __forceinline__ float sigmoid_f(float x) { return __builtin_amdgcn_rcpf(1.f + __builtin_amdgcn_exp2f(-1.4426950408889634f * x)); }
__device__ __forceinline__ s16x4 vtr(lds_cptr p) { return __builtin_bit_cast(s16x4, __builtin_amdgcn_ds_read_tr16_b64_v4i16((__attribute__((address_space(3))) v4i16_t*)p)); }
__device__ __forceinline__ int block_id() { int b = (int)blockIdx.x; asm volatile("" : "+s"(b)); return b; }
__device__ __forceinline__ int lane_id() { unsigned z = 0u; asm volatile("" : "+s"(z)); return (int)__builtin_amdgcn_mbcnt_hi(~0u, __builtin_amdgcn_mbcnt_lo(~0u, z)); }
__device__ __forceinline__ int opaque_tid(int wv) { asm volatile("" : "+s"(wv)); int t = wv * 64 + lane_id(); asm volatile("" : "+v"(t)); return t; }
__device__ __forceinline__ float wave_sum(float v) {
#pragma unroll
  for (int o = 32; o > 0; o >>= 1) v += __shfl_xor(v, o);
  return v;
}


#define XB_TMO      128
#define XB_XCNT(j)  (256  + 64 * (j))
#define XB_XSUB(j)  (1280 + 64 * (j))
#define XB_XGEN(j)  (2304 + 64 * (j))
#define XB_TOP      3328
#define XB_TOPGEN   3392
#define XCD_BAR_WORDS 3456
#define XB_SPIN_CAP (1u << 18)
#define LAS __attribute__((address_space(3)))
__device__ __forceinline__ unsigned xb_ld(unsigned* p)              { return __hip_atomic_load(p, __ATOMIC_RELAXED, __HIP_MEMORY_SCOPE_AGENT); }
__device__ __forceinline__ unsigned xb_add(unsigned* p, unsigned v) { return __hip_atomic_fetch_add(p, v, __ATOMIC_RELAXED, __HIP_MEMORY_SCOPE_AGENT); }
__device__ __forceinline__ unsigned xb_xcc_id() { return (unsigned)__builtin_amdgcn_s_getreg((3 << 11) | 20) & 0xFu; }
#define XB_SPIN(cond, bar) do { unsigned _sp = 0; while (cond) { __builtin_amdgcn_s_sleep(1); \
    if ((++_sp & 255u) == 0u) { if (xb_ld(&(bar)[XB_TMO])) break; if (_sp > XB_SPIN_CAP) { atomicAdd(&(bar)[XB_TMO], 1u); break; } } } } while (0)
struct XcdBarrier { unsigned* bar; unsigned x; volatile LAS unsigned* st; };
__device__ __forceinline__ XcdBarrier xcd_barrier_post(unsigned* bar, volatile LAS unsigned* st) {
    XcdBarrier b; b.bar = bar; b.x = xb_xcc_id(); b.st = st;
    if (threadIdx.x == 0) (void)xb_add(&bar[XB_XCNT(b.x)], 1u);
    return b;
}
__device__ __forceinline__ void xcd_barrier_complete(unsigned* bar, unsigned x, unsigned& nloc, unsigned& nx) {
    const unsigned G = gridDim.x * gridDim.y * gridDim.z;
    unsigned sum, cnt, mine, sp = 0u;
    for (;;) {
        sum = 0u; cnt = 0u; mine = 0u;
#pragma unroll
        for (unsigned j = 0; j < 16; ++j) { const unsigned c = xb_ld(&bar[XB_XCNT(j)]); sum += c; cnt += (c > 0u) ? 1u : 0u; mine = (j == x) ? c : mine; }
        if (sum == G) break;
        __builtin_amdgcn_s_sleep(1);
        if ((++sp & 255u) == 0u) { if (xb_ld(&bar[XB_TMO])) break; if (sp > XB_SPIN_CAP) { atomicAdd(&bar[XB_TMO], 1u); break; } }
    }
    nloc = mine > 0u ? mine : 1u; nx = cnt > 0u ? cnt : 1u;
}
__device__ __forceinline__ void xcd_barrier(const XcdBarrier& b) {
    asm volatile("s_waitcnt vmcnt(0)" ::: "memory");
    __syncthreads();
    if (threadIdx.x == 0) {
        unsigned* bar = b.bar;
        __builtin_amdgcn_s_waitcnt(0);
        unsigned nloc = b.st[0], nx = b.st[1];
        if (nloc == 0u) { xcd_barrier_complete(bar, b.x, nloc, nx); b.st[0] = nloc; b.st[1] = nx; }
        const unsigned old = xb_add(&bar[XB_XSUB(b.x)], 1u);
        const unsigned gen = old / nloc;
        if (old + 1u == (gen + 1u) * nloc) {
            __builtin_amdgcn_fence(__ATOMIC_RELEASE, "agent");
            asm volatile("s_waitcnt vmcnt(0)" ::: "memory");
            const unsigned og = xb_add(&bar[XB_TOP], 1u);
            const unsigned tg = og / nx;
            if (og + 1u == (tg + 1u) * nx) xb_add(&bar[XB_TOPGEN], 1u);
            else XB_SPIN(xb_ld(&bar[XB_TOPGEN]) == tg, bar);
            __builtin_amdgcn_fence(__ATOMIC_ACQUIRE, "agent");
            xb_add(&bar[XB_XGEN(b.x)], 1u);
            asm volatile("s_waitcnt vmcnt(0)" ::: "memory");
        } else {
            XB_SPIN(xb_ld(&bar[XB_XGEN(b.x)]) == gen, bar);
            __builtin_amdgcn_fence(__ATOMIC_ACQUIRE, "agent");
            asm volatile("s_waitcnt vmcnt(0)" ::: "memory");
        }
    }
    __syncthreads();
}

__device__ __forceinline__ void hier_barrier(unsigned* bar, unsigned round, int wv) {
    asm volatile("s_waitcnt vmcnt(0)" ::: "memory");
    __syncthreads();
    if (wv == 0 && lane_id() == 0) {
        const unsigned G = gridDim.x, grp = blockIdx.x & 7u;
        const unsigned nloc = (G - grp + 7u) >> 3, nx = G < 8u ? G : 8u;
        __builtin_amdgcn_fence(__ATOMIC_RELEASE, "agent");
        asm volatile("s_waitcnt vmcnt(0)" ::: "memory");
        const unsigned old = xb_add(&bar[XB_XSUB(grp)], 1u);
        const unsigned gen = round;
        if (old + 1u == (gen + 1u) * nloc) {
            const unsigned og = xb_add(&bar[XB_TOP], 1u);
            const unsigned tg = round;
            if (og + 1u == (tg + 1u) * nx) xb_add(&bar[XB_TOPGEN], 1u);
            else while (xb_ld(&bar[XB_TOPGEN]) == tg) __builtin_amdgcn_s_sleep(1);
            xb_add(&bar[XB_XGEN(grp)], 1u);
        } else {
            while (xb_ld(&bar[XB_XGEN(grp)]) == gen) __builtin_amdgcn_s_sleep(1);
        }
        __builtin_amdgcn_fence(__ATOMIC_ACQUIRE, "agent");
        asm volatile("s_waitcnt vmcnt(0)" ::: "memory");
    }
    __syncthreads();
}
__device__ __forceinline__ void simple_barrier(unsigned* cnt, unsigned target) {
    asm volatile("s_waitcnt vmcnt(0)" ::: "memory");
    __syncthreads();
    if (threadIdx.x == 0) {
        __builtin_amdgcn_fence(__ATOMIC_RELEASE, "agent");
        asm volatile("s_waitcnt vmcnt(0)" ::: "memory");
        xb_add(cnt, 1u);
        while (xb_ld(cnt) < target) __builtin_amdgcn_s_sleep(1);
        __builtin_amdgcn_fence(__ATOMIC_ACQUIRE, "agent");
        asm volatile("s_waitcnt vmcnt(0)" ::: "memory");
    }
    __syncthreads();
}

struct ConvTile { const float* src; u16* dst; int N, K; };
__device__ __forceinline__ ConvTile conv_desc(const Params& p, int l, int t, const float* wp0, const float* wp1, const float* wp2) {
  ConvTile c;
  if (t < 1024) { c.src = p.w_in + (size_t)l * 1024 * 4096 + (size_t)((t >> 6) * 64) * 4096 + (t & 63) * 64; c.N = 4096; c.K = 1024; c.dst = p.wt_ig + (size_t)((t & 63) * 64) * 1024 + (t >> 6) * 64; }
  else if (t < 1792) { const int u = t - 1024; const int kt = u / 48, nt = u % 48; c.src = p.w_gate + (size_t)l * 1024 * 3072 + (size_t)(kt * 64) * 3072 + nt * 64; c.N = 3072; c.K = 1024; c.dst = p.wt_ig + (size_t)(4096 + nt * 64) * 1024 + kt * 64; }
  else if (t < 2176) { const int u = t - 1792; const int b = u >> 7, r = u & 127; const int kt = r >> 4, nt = r & 15;
    c.src = (b == 0 ? wp0 : (b == 1 ? wp1 : wp2)) + (size_t)l * 512 * 1024 + (size_t)(kt * 64) * 1024 + nt * 64; c.N = 1024; c.K = 512; c.dst = p.wt_p + ((size_t)b * 1024 + nt * 64) * 512 + kt * 64; }
  else { const int u = t - 2176; const int kt = u >> 4, nt = u & 15; c.src = p.w_out + (size_t)l * 1024 * 1024 + (size_t)(kt * 64) * 1024 + nt * 64; c.N = 1024; c.K = 1024; c.dst = p.wt_o + (size_t)(nt * 64) * 1024 + kt * 64; }
  return c;
}
__device__ __forceinline__ void conv_weights(const Params& p, int l, char* lds, int tid) {
  const float* wp0 = p.w_proj0; const float* wp1 = p.w_proj1; const float* wp2 = p.w_proj2;
  float* tile = (float*)lds;
  const int kk0 = tid >> 4, cc = (tid & 15) * 4;
  const int n = tid >> 3, kc = (tid & 7) * 8;
  int t = blockIdx.x;
  float4 v0 = make_float4(0.f, 0.f, 0.f, 0.f), v1 = v0; ConvTile c = conv_desc(p, l, t < 2432 ? t : 0, wp0, wp1, wp2);
  if (t < 2432) { v0 = *(const float4*)(c.src + (size_t)kk0 * c.N + cc); v1 = *(const float4*)(c.src + (size_t)(kk0 + 32) * c.N + cc); }
  while (t < 2432) {
    const int tn = t + gridDim.x;
    const ConvTile cn = conv_desc(p, l, tn < 2432 ? tn : 0, wp0, wp1, wp2);
    float4 n0 = v0, n1 = v1;
    if (tn < 2432) { n0 = *(const float4*)(cn.src + (size_t)kk0 * cn.N + cc); n1 = *(const float4*)(cn.src + (size_t)(kk0 + 32) * cn.N + cc); }
    __syncthreads();
    { float* tp = tile + kk0 * 65 + cc; tp[0] = v0.x; tp[1] = v0.y; tp[2] = v0.z; tp[3] = v0.w;
      float* tq = tile + (kk0 + 32) * 65 + cc; tq[0] = v1.x; tq[1] = v1.y; tq[2] = v1.z; tq[3] = v1.w; }
    __syncthreads();
    const unsigned w0 = cvtpk(tile[(kc + 0) * 65 + n], tile[(kc + 1) * 65 + n]), w1 = cvtpk(tile[(kc + 2) * 65 + n], tile[(kc + 3) * 65 + n]);
    const unsigned w2 = cvtpk(tile[(kc + 4) * 65 + n], tile[(kc + 5) * 65 + n]), w3 = cvtpk(tile[(kc + 6) * 65 + n], tile[(kc + 7) * 65 + n]);
    *(uint4*)(c.dst + (size_t)n * c.K + kc) = make_uint4(w0, w1, w2, w3);
    v0 = n0; v1 = n1; c = cn; t = tn;
  }
  __syncthreads();
}

__device__ __forceinline__ void phase_pre(const Params& p, char* lds, int wv) {
  const int tid = opaque_tid(wv), lane = tid & 63, wid = tid >> 6;
  const int gtid = blockIdx.x * NTHR + tid, gsz = gridDim.x * NTHR;
  for (int i = gtid; i < 1024; i += gsz) {
    const int pos = i >> 4, f = i & 15;
    const float inv = exp2f(-(float)f * 0.8304820237218406f);
    const float a = (float)pos * inv;
    p.rope[i] = __cosf(a); p.rope[1024 + i] = __sinf(a);
  }
  const float* c0 = p.cache0; const float* c1 = p.cache1; const float* c2 = p.cache2; const float* c3 = p.cache3;
  for (int i = gtid; i < 4 * 65536; i += gsz) {
    const int t = i >> 16; const int o = (i & 65535) * 8;
    const float* cs = t == 0 ? c0 : (t == 1 ? c1 : (t == 2 ? c2 : c3));
    const float4* s = (const float4*)(cs + o); const float4 a = s[0], b = s[1];
    *(uint4*)(p.cachebf + (size_t)t * 524288 + o) = make_uint4(cvtpk(a.x, a.y), cvtpk(a.z, a.w), cvtpk(b.x, b.y), cvtpk(b.z, b.w));
  }
  for (int i = gtid; i < 32768; i += gsz) {
    const float4* s = (const float4*)(p.w_spatial + (size_t)i * 8); const float4 a = s[0], b = s[1];
    *(uint4*)(p.wsp + (size_t)i * 8) = make_uint4(cvtpk(a.x, a.y), cvtpk(a.z, a.w), cvtpk(b.x, b.y), cvtpk(b.z, b.w));
  }
  float* red = (float*)lds;
  for (int task = blockIdx.x; task < 192; task += gridDim.x) {
    const int l = task / 48, n0 = (task % 48) * 64;
    const int ksub = lane >> 4, c4 = (lane & 15) * 4;
    const float* W = p.w_mod + (size_t)l * 1024 * 3072 + n0 + c4;
    f32x4 a0 = {0.f, 0.f, 0.f, 0.f}, a1 = a0, a2 = a0;
#pragma unroll 16
    for (int it = 0; it < 32; ++it) {
      const int k = wid * 128 + it * 4 + ksub;
      const f32x4 w = *(const f32x4*)(W + (size_t)k * 3072);
      a0 += silu_f(p.c[k]) * w; a1 += silu_f(p.c[1024 + k]) * w; a2 += silu_f(p.c_ctx[k]) * w;
    }
#pragma unroll
    for (int j = 0; j < 4; ++j) {
      a0[j] += __shfl_xor(a0[j], 16); a0[j] += __shfl_xor(a0[j], 32);
      a1[j] += __shfl_xor(a1[j], 16); a1[j] += __shfl_xor(a1[j], 32);
      a2[j] += __shfl_xor(a2[j], 16); a2[j] += __shfl_xor(a2[j], 32);
    }
    __syncthreads();
    if (lane < 16) { *(f32x4*)(red + (wid * 3 + 0) * 64 + c4) = a0; *(f32x4*)(red + (wid * 3 + 1) * 64 + c4) = a1; *(f32x4*)(red + (wid * 3 + 2) * 64 + c4) = a2; }
    __syncthreads();
    if (wid < 3) {
      float s = 0.f;
#pragma unroll
      for (int w = 0; w < 8; ++w) s += red[(w * 3 + wid) * 64 + lane];
      p.mod[(l * 3 + wid) * 3072 + n0 + lane] = s + p.b_mod[l * 3072 + n0 + lane];
    }
  }
  conv_weights(p, 0, lds, tid);
}

__device__ __forceinline__ void phase_row(const Params& p, int l, char* lds, int wv) {
  const int tid = opaque_tid(wv), lane = tid & 63, wid = tid >> 6;
  const int rstride = gridDim.x * NWAVE;
  for (int row0 = blockIdx.x * NWAVE + wid; row0 < NTOK; row0 += 2 * rstride) {
    f32x4 v[2][4];
#pragma unroll
    for (int u = 0; u < 2; ++u) {
      const int row = row0 + u * rstride;
      if (row < NTOK) {
        const float* src = (l == 0) ? (row < NCTX ? p.x_prompt + (size_t)row * 1024 : p.x_sample + (size_t)(row - NCTX) * 1024) : p.out + (size_t)row * 1024;
#pragma unroll
        for (int j = 0; j < 4; ++j) v[u][j] = *(const f32x4*)(src + j * 256 + lane * 4);
      }
    }
#pragma unroll
    for (int u = 0; u < 2; ++u) {
      const int row = row0 + u * rstride;
      if (row < NTOK) {
        if (l > 0) {
          float s = 0.f;
#pragma unroll
          for (int j = 0; j < 4; ++j) s += v[u][j][0] + v[u][j][1] + v[u][j][2] + v[u][j][3];
          const float mean = wave_sum(s) * (1.f / 1024.f);
          float q = 0.f;
#pragma unroll
          for (int j = 0; j < 4; ++j) { v[u][j] -= mean; q += v[u][j][0] * v[u][j][0] + v[u][j][1] * v[u][j][1] + v[u][j][2] * v[u][j][2] + v[u][j][3] * v[u][j][3]; }
          const float rstd = rsqrtf(wave_sum(q) * (1.f / 1024.f) + LN_EPS);
#pragma unroll
          for (int j = 0; j < 4; ++j) {
            const f32x4 g = *(const f32x4*)(p.ln_g + (l - 1) * 1024 + j * 256 + lane * 4), b = *(const f32x4*)(p.ln_b + (l - 1) * 1024 + j * 256 + lane * 4);
            v[u][j] = v[u][j] * rstd * g + b;
            *(f32x4*)(p.out + (size_t)row * 1024 + j * 256 + lane * 4) = v[u][j];
          }
        }
        if (l < 4) {
          float s = 0.f;
#pragma unroll
          for (int j = 0; j < 4; ++j) s += v[u][j][0] + v[u][j][1] + v[u][j][2] + v[u][j][3];
          const float mean = wave_sum(s) * (1.f / 1024.f);
          float q = 0.f;
#pragma unroll
          for (int j = 0; j < 4; ++j) { v[u][j] -= mean; q += v[u][j][0] * v[u][j][0] + v[u][j][1] * v[u][j][1] + v[u][j][2] * v[u][j][2] + v[u][j][3] * v[u][j][3]; }
          const float rstd = rsqrtf(wave_sum(q) * (1.f / 1024.f) + LN_EPS);
          const int mv = row < NCTX ? 2 : ((row - NCTX) >> 11);
          const float* md = p.mod + (l * 3 + mv) * 3072;
#pragma unroll
          for (int j = 0; j < 4; ++j) {
            const f32x4 sh = *(const f32x4*)(md + j * 256 + lane * 4), sc = *(const f32x4*)(md + 1024 + j * 256 + lane * 4);
            const f32x4 h = v[u][j] * rstd * (1.f + sc) + sh;
            *(uint2*)(p.H + (size_t)row * 1024 + j * 256 + lane * 4) = make_uint2(cvtpk(h[0], h[1]), cvtpk(h[2], h[3]));
          }
        }
      }
    }
  }
  if (l > 0 && l < 4) conv_weights(p, l, lds, tid);
}

constexpr int G_BK = 64, G_HALF = 128, G_HTB = G_HALF * G_BK * 2;
__device__ __forceinline__ int lds_byte(int r, int c) { const int st = (r >> 4) * 2 + (c >> 5), rr = r & 15, cc = c & 31, ob = rr * 64 + cc * 2; return st * 1024 + (ob ^ (((ob >> 9) & 1) << 5)); }
__device__ __forceinline__ void stage_rc(int b, int& R, int& C) { const int st = b / 1024, sb = b % 1024, swz = sb ^ (((sb >> 9) & 1) << 5); R = (st >> 1) * 16 + swz / 64; C = (st & 1) * 32 + (swz % 64) / 2; }
struct Unit { const char* a; const char* b; int pm, pn, aux; };

template <class Epi, class Sched>
__device__ __forceinline__ void gemm_phase(LAS unsigned char* lds, const int K, const int lda, const int ldb, const Sched& S, const Epi& E, const int tid) {
    const int wid = __builtin_amdgcn_readfirstlane(tid >> 6), lane = tid & 63, wr = wid >> 2, wc = wid & 3, fr = lane & 15, fq = lane >> 4;
    const int nt = K / G_BK;
    unsigned voffA[2], voffB[2];
#pragma unroll
    for (int i = 0; i < 2; ++i) { int R, C; stage_rc(tid * 16 + i * 8192, R, C); const int rho = R & 63, Ra = (R & ~63) + 32 * (rho >> 5) + 8 * ((rho >> 2) & 3) + 4 * ((rho >> 4) & 1) + (rho & 3);
        voffA[i] = (unsigned)(Ra * lda + C) * 2u; voffB[i] = (unsigned)(R * ldb + C) * 2u; }
    const size_t kstep = (size_t)(G_BK * 2);
    const size_t hstepA = (size_t)G_HALF * lda * 2, hstepB = (size_t)G_HALF * ldb * 2;
    const unsigned ldsw = (unsigned)wid * 1024u;
    const int aoff = lds_byte(wr * 64 + fr, fq * 8), boff = lds_byte(wc * 32 + fr, fq * 8);
#define PG8_SA(b, h) (((b) * 2 + (h)) * G_HTB)
#define PG8_SB(b, h) ((4 + (b) * 2 + (h)) * G_HTB)
#define PG8_STAGE(bufoff, gbase, voff) do { _Pragma("unroll") for (int _i = 0; _i < 2; ++_i) \
        __builtin_amdgcn_global_load_lds((const unsigned*)((const char*)(gbase) + (voff)[_i]), (LAS unsigned*)(lds + (bufoff) + ldsw + _i * 8192), 16, 0, 0); } while (0)
#define PG8_LDA(dst, b, h) do { _Pragma("unroll") for (int m = 0; m < 4; ++m) _Pragma("unroll") for (int k = 0; k < 2; ++k) dst[m][k] = *(const LAS bf16x8*)(lds + PG8_SA(b, h) + aoff + m * 2048 + k * 1024); } while (0)
#define PG8_LDB(dst, b, h) do { _Pragma("unroll") for (int n = 0; n < 2; ++n) _Pragma("unroll") for (int k = 0; k < 2; ++k) dst[n][k] = *(const LAS bf16x8*)(lds + PG8_SB(b, h) + boff + n * 2048 + k * 1024); } while (0)
#define PG8_MMA(ai, bj, At, Bt) do { __builtin_amdgcn_s_setprio(1); _Pragma("unroll") for (int m = 0; m < 4; ++m) _Pragma("unroll") for (int n = 0; n < 2; ++n) _Pragma("unroll") for (int k = 0; k < 2; ++k) \
        acc[ai][bj][m][n] = __builtin_amdgcn_mfma_f32_16x16x32_bf16(At[m][k], Bt[n][k], acc[ai][bj][m][n], 0, 0, 0); __builtin_amdgcn_s_setprio(0); } while (0)
#define PG8_WAIT_V(n) asm volatile("s_waitcnt vmcnt(" #n ")" ::: "memory")
#define PG8_WAIT_L(n) asm volatile("s_waitcnt lgkmcnt(" #n ")" ::: "memory")
#define PG8_BAR __builtin_amdgcn_s_barrier()
#define PG8_SCHED __builtin_amdgcn_sched_barrier(0)
    Unit cur, nxt; int ui = 0;
    if (!S.next(0, cur)) return;
    f32x4_t acc[2][2][4][2];
#pragma unroll
    for (int a = 0; a < 2; ++a)
#pragma unroll
        for (int b = 0; b < 2; ++b)
#pragma unroll
            for (int m = 0; m < 4; ++m)
#pragma unroll
                for (int n = 0; n < 2; ++n) acc[a][b][m][n] = (f32x4_t){0.f, 0.f, 0.f, 0.f};
    bf16x8 At[4][2], B0[2][2], B1[2][2];
    const char* cA = cur.a; const char* cB = cur.b;
    PG8_STAGE(PG8_SB(0, 0), cB, voffB); PG8_STAGE(PG8_SA(0, 0), cA, voffA); PG8_STAGE(PG8_SB(0, 1), cB + hstepB, voffB); PG8_STAGE(PG8_SA(0, 1), cA + hstepA, voffA);
    if (wr == 1) PG8_BAR;
    PG8_WAIT_V(4); PG8_BAR;
    PG8_STAGE(PG8_SB(1, 0), cB + kstep, voffB); PG8_STAGE(PG8_SA(1, 0), cA + kstep, voffA); PG8_STAGE(PG8_SB(1, 1), cB + hstepB + kstep, voffB);
    PG8_WAIT_V(6); PG8_BAR;
    for (;;) {
        const bool has_next = S.next(ui + 1, nxt);
        const char* nA = has_next ? nxt.a : cA; const char* nB = has_next ? nxt.b : cB;
        for (int t = 0; t < nt; t += 2) {
            const bool last = (t == nt - 2);
            const char* a1 = cA + (size_t)(t + 1) * kstep;
            const char* a2 = last ? nA : cA + (size_t)(t + 2) * kstep; const char* b2 = last ? nB : cB + (size_t)(t + 2) * kstep;
            const char* a3 = a2 + kstep; const char* b3 = b2 + kstep;
            PG8_LDB(B0, 0, 0); PG8_SCHED; PG8_LDA(At, 0, 0); PG8_STAGE(PG8_SA(1, 1), a1 + hstepA, voffA);
            PG8_WAIT_L(8); PG8_BAR; PG8_WAIT_L(0); PG8_MMA(0, 0, At, B0); PG8_BAR; PG8_SCHED;
            PG8_LDB(B1, 0, 1); PG8_STAGE(PG8_SB(0, 0), b2, voffB);
            PG8_BAR; PG8_WAIT_L(0); PG8_MMA(0, 1, At, B1); PG8_BAR;
            PG8_LDA(At, 0, 1); PG8_STAGE(PG8_SA(0, 0), a2, voffA);
            PG8_BAR; PG8_WAIT_L(0); PG8_MMA(1, 0, At, B0); PG8_BAR; PG8_SCHED;
            PG8_STAGE(PG8_SB(0, 1), b2 + hstepB, voffB);
            PG8_WAIT_V(6); PG8_BAR; PG8_MMA(1, 1, At, B1); PG8_BAR;
            PG8_LDB(B0, 1, 0); PG8_SCHED; PG8_LDA(At, 1, 0); PG8_STAGE(PG8_SA(0, 1), a2 + hstepA, voffA);
            PG8_WAIT_L(8); PG8_BAR; PG8_WAIT_L(0); PG8_MMA(0, 0, At, B0); PG8_BAR; PG8_SCHED;
            PG8_LDB(B1, 1, 1); PG8_STAGE(PG8_SB(1, 0), b3, voffB);
            PG8_BAR; PG8_WAIT_L(0); PG8_MMA(0, 1, At, B1); PG8_BAR;
            PG8_LDA(At, 1, 1); PG8_STAGE(PG8_SA(1, 0), a3, voffA);
            PG8_BAR; PG8_WAIT_L(0); PG8_MMA(1, 0, At, B0); PG8_BAR; PG8_SCHED;
            PG8_STAGE(PG8_SB(1, 1), b3 + hstepB, voffB);
            PG8_WAIT_V(6); PG8_BAR; PG8_MMA(1, 1, At, B1); PG8_BAR;
        }
        E(acc, cur, wid, wr, wc, fr, fq, lane);
        if (!has_next) break;
        if (!E.keep_acc(cur)) {
#pragma unroll
        for (int a = 0; a < 2; ++a)
#pragma unroll
            for (int b = 0; b < 2; ++b)
#pragma unroll
                for (int m = 0; m < 4; ++m)
#pragma unroll
                    for (int n = 0; n < 2; ++n) acc[a][b][m][n] = (f32x4_t){0.f, 0.f, 0.f, 0.f};
        }
        cur = nxt; cA = nA; cB = nB; ++ui;
    }
    PG8_WAIT_V(0);
    if (wr == 0) PG8_BAR;
    PG8_BAR;
#undef PG8_SA
#undef PG8_SB
#undef PG8_STAGE
#undef PG8_LDA
#undef PG8_LDB
#undef PG8_MMA
#undef PG8_WAIT_V
#undef PG8_WAIT_L
#undef PG8_BAR
#undef PG8_SCHED
}

__device__ __forceinline__ void tile_of(int L, int nM, int nN, int& pm, int& pn) {
  const int nwg = nM * nN;
  int wgid = L; { const int q = nwg / 8, r = nwg % 8, xcd = wgid % 8, off = wgid / 8; wgid = (xcd < r ? xcd * (q + 1) : r * (q + 1) + (xcd - r) * q) + off; }
  const int nig = 8 * nN, gid = wgid / nig, fm = gid * 8, gsz = (nM - fm) < 8 ? (nM - fm) : 8;
  pm = fm + ((wgid % nig) % gsz); pn = (wgid % nig) / gsz;
}

struct SchedP2 {
  const char* A; const char* B; int G, c;
  __device__ __forceinline__ bool next(int i, Unit& u) const {
    const int L = i * G + c; if (L >= 16 * 48) return false;
    tile_of(L, 16, 48, u.pm, u.pn); u.aux = 0;
    u.pm = (u.pm & 1) * 8 + (u.pm >> 1);
    u.pn = (u.pn & 3) * 12 + (u.pn >> 2);
    u.a = A + (size_t)u.pm * 256 * 1024 * 2; u.b = B + (size_t)u.pn * 256 * 1024 * 2; return true;
  }
};
struct EpiP2 {
  __device__ __forceinline__ bool keep_acc(const Unit&) const { return false; }
  const float* b_gate; const float* q_norm; const float* k_norm; const float* rope; float* so; u16* P; u16* G; int l;
  __device__ __forceinline__ void operator()(f32x4_t (&acc)[2][2][4][2], const Unit& u, int wid, int wr, int wc, int fr, int fq, int lane) const {
    const int f0 = u.pm * 256, t0 = u.pn * 256;
    const bool lat = t0 >= NCTX;
#pragma unroll
    for (int ai = 0; ai < 2; ++ai) {
      const int fb = f0 + 128 * ai + 64 * wr;
      int norm = 0, kvh = 0; bool rp = false, act = false; float scl = 1.f; float* st = nullptr;
      if (fb < 512) { norm = 1; rp = lat; scl = 0.18033688011112042f; }
      else if (fb < 640) { norm = 2; rp = lat; kvh = (fb - 512) >> 6; if (!lat) st = so; }
      else if (fb < 768) { kvh = (fb - 640) >> 6; if (!lat) st = so + 4194304; }
      else if (fb < 1280) { act = true; }
      else if (fb < 1792) { rp = lat; scl = 0.18033688011112042f; }
      else if (fb < 1920) { rp = lat; kvh = (fb - 1792) >> 6; if (!lat) st = so + 2 * 4194304; }
      else if (fb < 2048) { kvh = (fb - 1920) >> 6; if (!lat) st = so + 3 * 4194304; }
      else if (fb < 2560) { act = true; }
      else if (fb < 3584) { }
      else { act = true; }
      if (norm) {
        f32x4_t gn[4];
#pragma unroll
        for (int m = 0; m < 4; ++m) {
          const int dd = 32 * (m >> 1) + 8 * fq + 4 * (m & 1);
          const f32x4_t gq = *(const f32x4_t*)(q_norm + l * 64 + dd), gk = *(const f32x4_t*)(k_norm + l * 64 + dd);
          gn[m] = norm == 1 ? gq : gk;
        }
#pragma unroll
        for (int bj = 0; bj < 2; ++bj)
#pragma unroll
          for (int n = 0; n < 2; ++n) {
            float ss = 0.f;
#pragma unroll
            for (int m = 0; m < 4; ++m) { const f32x4_t x = acc[ai][bj][m][n]; ss += x[0] * x[0] + x[1] * x[1] + x[2] * x[2] + x[3] * x[3]; }
            ss += __shfl_xor(ss, 16); ss += __shfl_xor(ss, 32);
            const float rs = rsqrtf(ss * (1.f / 64.f) + LN_EPS);
#pragma unroll
            for (int m = 0; m < 4; ++m) acc[ai][bj][m][n] = acc[ai][bj][m][n] * rs * gn[m];
          }
      }
      if (st) {
#pragma unroll
        for (int bj = 0; bj < 2; ++bj)
#pragma unroll
          for (int n = 0; n < 2; ++n) {
            const int token = t0 + 128 * bj + 32 * wc + 16 * n + fr;
            float* o = st + ((size_t)((token >> 8) * 4 + l) * 256 + (token & 255)) * 128 + kvh * 64 + 8 * fq;
#pragma unroll
            for (int m = 0; m < 4; ++m) *(f32x4_t*)(o + 32 * (m >> 1) + 4 * (m & 1)) = acc[ai][bj][m][n];
          }
      }
      if (rp) {
#pragma unroll
        for (int bj = 0; bj < 2; ++bj) {
          f32x4_t c4[2][2], s4[2][2];
#pragma unroll
          for (int n = 0; n < 2; ++n) {
            const int token = t0 + 128 * bj + 32 * wc + 16 * n + fr;
            const int nn = (token - NCTX) & 2047;
            const int pos = fq < 2 ? (nn >> 6) : (nn & 63);
#pragma unroll
            for (int m = 0; m < 2; ++m) {
              const int fo = pos * 16 + 8 * (fq & 1) + 4 * m;
              c4[n][m] = *(const f32x4_t*)(rope + fo); s4[n][m] = *(const f32x4_t*)(rope + 1024 + fo);
            }
          }
#pragma unroll
          for (int n = 0; n < 2; ++n)
#pragma unroll
            for (int m = 0; m < 2; ++m) {
              const f32x4_t x1 = acc[ai][bj][m][n], x2 = acc[ai][bj][m + 2][n];
              acc[ai][bj][m][n] = x1 * c4[n][m] - x2 * s4[n][m]; acc[ai][bj][m + 2][n] = x2 * c4[n][m] + x1 * s4[n][m];
            }
        }
      }
#pragma unroll
      for (int bj = 0; bj < 2; ++bj)
#pragma unroll
        for (int n = 0; n < 2; ++n) {
          const int token = t0 + 128 * bj + 32 * wc + 16 * n + fr;
          u16* dp = P + (size_t)token * LDP + fb + 8 * fq;
#pragma unroll
          for (int mp = 0; mp < 2; ++mp) {
            f32x4_t y0 = acc[ai][bj][2 * mp][n] * scl, y1 = acc[ai][bj][2 * mp + 1][n] * scl;
            if (act) { y0[0] = silu_f(y0[0]); y0[1] = silu_f(y0[1]); y0[2] = silu_f(y0[2]); y0[3] = silu_f(y0[3]); y1[0] = silu_f(y1[0]); y1[1] = silu_f(y1[1]); y1[2] = silu_f(y1[2]); y1[3] = silu_f(y1[3]); }
            *(uint4*)(dp + 32 * mp) = make_uint4(cvtpk(y0[0], y0[1]), cvtpk(y0[2], y0[3]), cvtpk(y1[0], y1[1]), cvtpk(y1[2], y1[3]));
          }
        }
    }
  }
};

struct EpiGate {
  __device__ __forceinline__ bool keep_acc(const Unit&) const { return false; }
  const float* b_gate; u16* G; int l;
  __device__ __forceinline__ void operator()(f32x4_t (&acc)[2][2][4][2], const Unit& u, int wid, int wr, int wc, int fr, int fq, int lane) const {
    const int f0 = u.pm * 256;
    if (f0 >= 4096) {
      const int ug = (u.pm - 16) * 48 + u.pn;
      uint4* dst = (uint4*)G + ((size_t)(ug * 8 + wid) * 16) * 64 + lane;
#pragma unroll
      for (int ai = 0; ai < 2; ++ai)
#pragma unroll
        for (int m = 0; m < 4; ++m) {
          const f32x4_t bv = *(const f32x4_t*)(b_gate + l * 3072 + (f0 - 4096) + 128 * ai + 64 * wr + 32 * (m >> 1) + 8 * fq + 4 * (m & 1));
#pragma unroll
          for (int bj = 0; bj < 2; ++bj)
#pragma unroll
            for (int n = 0; n < 2; ++n) {
              f32x4_t x = acc[ai][bj][m][n] + bv;
              x[0] = sigmoid_f(x[0]); x[1] = sigmoid_f(x[1]); x[2] = sigmoid_f(x[2]); x[3] = sigmoid_f(x[3]);
              acc[ai][bj][m][n] = x;
            }
        }
#pragma unroll
      for (int ai = 0; ai < 2; ++ai)
#pragma unroll
        for (int m = 0; m < 4; ++m)
#pragma unroll
          for (int bj = 0; bj < 2; ++bj) {
            const f32x4_t x0 = acc[ai][bj][m][0], x1 = acc[ai][bj][m][1];
            dst[((ai * 2 + bj) * 4 + m) * 64] = make_uint4(cvtpk(x0[0], x0[1]), cvtpk(x0[2], x0[3]), cvtpk(x1[0], x1[1]), cvtpk(x1[2], x1[3]));
          }
    }
  }
};

struct SchedGate {
  const char* A; const char* B; int item;
  __device__ __forceinline__ bool next(int i, Unit& u) const {
    if (i >= 2) return false;
    const int g = item * 2 + i; u.pm = 16 + g / 48; u.pn = g % 48; u.aux = 0;
    u.a = A + (size_t)u.pm * 256 * 1024 * 2; u.b = B + (size_t)u.pn * 256 * 1024 * 2; return true;
  }
};

struct SchedP4 {
  const char* A; const char* B; int c;
  __device__ __forceinline__ bool next(int i, Unit& u) const {
    if (c >= 192 || i >= 3) return false;
    tile_of(c, 4, 48, u.pm, u.pn); u.aux = i;
    u.a = A + ((size_t)i * 1024 + (size_t)u.pm * 256) * 512 * 2;
    u.b = B + ((size_t)u.pn * 256 * LDP + (i == 0 ? 0 : (i == 1 ? 1280 : 2560))) * 2; return true;
  }
};
struct EpiP4 {
  const u16* G; u16* Z;
  __device__ __forceinline__ bool keep_acc(const Unit& u) const { return u.aux < 2; }
  __device__ __forceinline__ void operator()(f32x4_t (&acc)[2][2][4][2], const Unit& u, int wid, int wr, int wc, int fr, int fq, int lane) const {
    const int br = u.aux;
    const uint4* gs = (const uint4*)G + ((size_t)(((br * 4 + u.pm) * 48 + u.pn) * 8 + wid) * 16) * 64 + lane;
    const uint4* gn = gs + (size_t)4 * 48 * 8 * 16 * 64;
#pragma unroll
    for (int ai = 0; ai < 2; ++ai)
#pragma unroll
    for (int bj = 0; bj < 2; ++bj) {
      uint4 gc[4], gx[4];
#pragma unroll
      for (int m = 0; m < 4; ++m) gc[m] = gs[((ai * 2 + bj) * 4 + m) * 64];
      if (br < 2) {
#pragma unroll
        for (int m = 0; m < 4; ++m) gx[m] = gn[((ai * 2 + bj) * 4 + m) * 64];
      }
#pragma unroll
      for (int m = 0; m < 4; ++m) {
          const uint4 g = gc[m];
          f32x4_t c0, c1;
          c0[0] = bflo(g.x); c0[1] = bfhi(g.x); c0[2] = bflo(g.y); c0[3] = bfhi(g.y);
          c1[0] = bflo(g.z); c1[1] = bfhi(g.z); c1[2] = bflo(g.w); c1[3] = bfhi(g.w);
          if (br > 0) {
#pragma unroll
            for (int j = 0; j < 4; ++j) { c0[j] = fmaxf(c0[j], 1e-30f); c1[j] = fmaxf(c1[j], 1e-30f); }
          }
          if (br < 2) {
            const uint4 h = gx[m];
            c0[0] *= __builtin_amdgcn_rcpf(fmaxf(bflo(h.x), 1e-30f)); c0[1] *= __builtin_amdgcn_rcpf(fmaxf(bfhi(h.x), 1e-30f)); c0[2] *= __builtin_amdgcn_rcpf(fmaxf(bflo(h.y), 1e-30f)); c0[3] *= __builtin_amdgcn_rcpf(fmaxf(bfhi(h.y), 1e-30f));
            c1[0] *= __builtin_amdgcn_rcpf(fmaxf(bflo(h.z), 1e-30f)); c1[1] *= __builtin_amdgcn_rcpf(fmaxf(bfhi(h.z), 1e-30f)); c1[2] *= __builtin_amdgcn_rcpf(fmaxf(bflo(h.w), 1e-30f)); c1[3] *= __builtin_amdgcn_rcpf(fmaxf(bfhi(h.w), 1e-30f));
            acc[ai][bj][m][0] *= c0; acc[ai][bj][m][1] *= c1;
          } else {
            acc[ai][bj][m][0] *= c0; acc[ai][bj][m][1] *= c1;
          }
      }
      if (br == 2) {
        const int tk = u.pn * 256 + 128 * bj + 32 * wc + fr;
        u16* zp = Z + (size_t)tk * 1024 + u.pm * 256 + 128 * ai + 64 * wr + 8 * fq;
#pragma unroll
        for (int mp = 0; mp < 2; ++mp) {
          const f32x4_t a0 = acc[ai][bj][2 * mp][0], a1 = acc[ai][bj][2 * mp + 1][0], b0 = acc[ai][bj][2 * mp][1], b1 = acc[ai][bj][2 * mp + 1][1];
          *(uint4*)(zp + 32 * mp) = make_uint4(cvtpk(a0[0], a0[1]), cvtpk(a0[2], a0[3]), cvtpk(a1[0], a1[1]), cvtpk(a1[2], a1[3]));
          *(uint4*)(zp + 16 * 1024 + 32 * mp) = make_uint4(cvtpk(b0[0], b0[1]), cvtpk(b0[2], b0[3]), cvtpk(b1[0], b1[1]), cvtpk(b1[2], b1[3]));
        }
      }
    }
  }
};

struct SchedP5 {
  const char* A; const char* B; int c;
  __device__ __forceinline__ bool next(int i, Unit& u) const {
    if (c >= 192 || i >= 1) return false;
    tile_of(c, 4, 48, u.pm, u.pn); u.aux = 0;
    u.a = A + (size_t)u.pm * 256 * 1024 * 2; u.b = B + (size_t)u.pn * 256 * 1024 * 2; return true;
  }
};
struct EpiP5 {
  const float* mod; const float* xp; const float* xs; float* out; int l;
  __device__ __forceinline__ bool keep_acc(const Unit&) const { return false; }
  __device__ __forceinline__ void operator()(f32x4_t (&acc)[2][2][4][2], const Unit& u, int wid, int wr, int wc, int fr, int fq, int lane) const {
    const int t0 = u.pn * 256;
    const int mv = t0 < NCTX ? 2 : ((t0 - NCTX) >> 11);
    const float* gt = mod + (l * 3 + mv) * 3072 + 2048 + u.pm * 256 + 64 * wr + 8 * fq;
    f32x4_t gv[2][4];
#pragma unroll
    for (int ai = 0; ai < 2; ++ai)
#pragma unroll
      for (int m = 0; m < 4; ++m) gv[ai][m] = *(const f32x4_t*)(gt + 128 * ai + 32 * (m >> 1) + 4 * (m & 1));
#pragma unroll
    for (int bj = 0; bj < 2; ++bj)
#pragma unroll
      for (int n = 0; n < 2; ++n) {
        const int token = t0 + 128 * bj + 32 * wc + 16 * n + fr;
        const float* xsrc = ((l == 0) ? (token < NCTX ? xp + (size_t)token * 1024 : xs + (size_t)(token - NCTX) * 1024) : out + (size_t)token * 1024) + u.pm * 256 + 64 * wr + 8 * fq;
        float* od = out + (size_t)token * 1024 + u.pm * 256 + 64 * wr + 8 * fq;
        f32x4_t xv[2][4];
#pragma unroll
        for (int ai = 0; ai < 2; ++ai)
#pragma unroll
          for (int m = 0; m < 4; ++m) xv[ai][m] = *(const f32x4_t*)(xsrc + 128 * ai + 32 * (m >> 1) + 4 * (m & 1));
#pragma unroll
        for (int ai = 0; ai < 2; ++ai)
#pragma unroll
          for (int m = 0; m < 4; ++m) *(f32x4_t*)(od + 128 * ai + 32 * (m >> 1) + 4 * (m & 1)) = ALPHA * xv[ai][m] + gv[ai][m] * acc[ai][bj][m][n];
      }
  }
};

__device__ __forceinline__ void attn_item(u16* Qp, const u16* Gp,
                          const u16* K0, const u16* V0, int ld0, int n0, bool masked, int kpos0, int qpos0,
                          const u16* K1, const u16* V1, int ld1, int n1, bool has_sink, float sink, char* lds, int tid_in) {
  int tid = tid_in; asm volatile("" : "+v"(tid));
  const int lane = tid & 63, wid = tid >> 6, r32 = lane & 31, hi = lane >> 5;
  bf16x8 qr[4];
#pragma unroll
  for (int d0 = 0; d0 < 4; ++d0) qr[d0] = *(const bf16x8*)(Qp + (size_t)(wid * 32 + r32) * LDP + d0 * 16 + hi * 8);
  const int np0 = n0 >> 7, NI = np0 + (n1 >> 7);
  uint4 kr0, kr1, vr0, vr1;
#define ATT_GLOAD(i_) do { const int i__ = (i_); const u16 *kp, *vp; int ld; \
    if (i__ < np0) { kp = K0 + (size_t)i__ * 128 * ld0; vp = V0 + (size_t)i__ * 128 * ld0; ld = ld0; } \
    else { kp = K1 + (size_t)(i__ - np0) * 128 * ld1; vp = V1 + (size_t)(i__ - np0) * 128 * ld1; ld = ld1; } \
    kr0 = *(const uint4*)(kp + (size_t)(tid >> 3) * ld + (tid & 7) * 8); \
    kr1 = *(const uint4*)(kp + (size_t)(64 + (tid >> 3)) * ld + (tid & 7) * 8); \
    vr0 = *(const uint4*)(vp + (size_t)((tid & 255) >> 2) * ld + (tid >> 8) * 32 + (tid & 3) * 8); \
    vr1 = *(const uint4*)(vp + (size_t)(64 + ((tid & 255) >> 2)) * ld + (tid >> 8) * 32 + (tid & 3) * 8); } while (0)
#define ATT_LWRITE(buf_) do { const int b__ = (buf_); \
    *(uint4*)(lds + b__ * 18432 + (tid >> 3) * 144 + (tid & 7) * 16) = kr0; \
    *(uint4*)(lds + b__ * 18432 + 9216 + (tid >> 3) * 144 + (tid & 7) * 16) = kr1; \
    *(uint4*)(lds + 36864 + b__ * 16384 + tid * 16) = vr0; \
    *(uint4*)(lds + 36864 + b__ * 16384 + 8192 + tid * 16) = vr1; } while (0)
  f32x16 o[2];
#pragma unroll
  for (int r = 0; r < 16; ++r) { o[0][r] = 0.f; o[1][r] = 0.f; }
  float m = -1e30f, lsum = 0.f;
  const int qpos = qpos0 + wid * 32 + r32;
  const int vlane = ((lane >> 4) & 1) * 32 + (lane & 3) * 8 + (4 * hi + ((lane & 15) >> 2)) * 64;
#define ATT_MASK(sa, sb, tt_) do { const int kb0 = kpos0 + (tt_) * 64 + 4 * hi; \
      _Pragma("unroll") for (int r = 0; r < 16; ++r) { \
        const int kp = kb0 + (r & 3) + 8 * (r >> 2); \
        int e0 = qpos - kp; e0 = e0 < 0 ? -e0 : e0; \
        int e1 = qpos - kp - 32; e1 = e1 < 0 ? -e1 : e1; \
        if (e0 > 128) sa[r] = -1e30f; \
        if (e1 > 128) sb[r] = -1e30f; } } while (0)
#define ATT_PACK(sx, h_) __builtin_bit_cast(bf16x8, make_uint4(cvtpk(sx[8 * (h_) + 0], sx[8 * (h_) + 1]), cvtpk(sx[8 * (h_) + 2], sx[8 * (h_) + 3]), cvtpk(sx[8 * (h_) + 4], sx[8 * (h_) + 5]), cvtpk(sx[8 * (h_) + 6], sx[8 * (h_) + 7])))
#define ATT_PV1(vb_, off_, pf_) do { \
    _Pragma("unroll") for (int db = 0; db < 2; ++db) { \
      const lds_cptr vp_ = (vb_) + db * 4096 + (off_) * 64; \
      const s16x4 lo_ = vtr(vp_), hh_ = vtr(vp_ + 512); \
      const bf16x8 vf_ = (bf16x8){lo_[0], lo_[1], lo_[2], lo_[3], hh_[0], hh_[1], hh_[2], hh_[3]}; \
      o[db] = MFMA(vf_, pf_, o[db]); } } while (0)
  ATT_GLOAD(0); ATT_LWRITE(0);
  __syncthreads();
  for (int i = 0; i < NI; ++i) {
    const int buf = i & 1;
    if (i + 1 < NI) ATT_GLOAD(i + 1);
    const char* kb_ = lds + buf * 18432 + r32 * 144 + hi * 16;
    f32x16 s0, s1, s2, s3;
#pragma unroll
    for (int r = 0; r < 16; ++r) { s0[r] = 0.f; s1[r] = 0.f; s2[r] = 0.f; s3[r] = 0.f; }
#pragma unroll
    for (int d0 = 0; d0 < 4; ++d0) {
      const bf16x8 k0 = *(const bf16x8*)(kb_ + d0 * 32), k1 = *(const bf16x8*)(kb_ + 32 * 144 + d0 * 32);
      const bf16x8 k2 = *(const bf16x8*)(kb_ + 9216 + d0 * 32), k3 = *(const bf16x8*)(kb_ + 9216 + 32 * 144 + d0 * 32);
      s0 = MFMA(k0, qr[d0], s0); s1 = MFMA(k1, qr[d0], s1); s2 = MFMA(k2, qr[d0], s2); s3 = MFMA(k3, qr[d0], s3);
    }
    if (masked && i < np0) { ATT_MASK(s0, s1, 2 * i); ATT_MASK(s2, s3, 2 * i + 1); }
    float mx = fmaxf(fmaxf(s0[0], s1[0]), fmaxf(s2[0], s3[0]));
#pragma unroll
    for (int r = 1; r < 16; ++r) mx = fmaxf(mx, fmaxf(fmaxf(s0[r], s1[r]), fmaxf(s2[r], s3[r])));
    mx = fmaxf(mx, __shfl_xor(mx, 32));
    if (__any(mx > m)) {
      const float mn = fmaxf(m, mx); const float alpha = __builtin_amdgcn_exp2f(m - mn); m = mn; lsum *= alpha;
#pragma unroll
      for (int r = 0; r < 16; ++r) { o[0][r] *= alpha; o[1][r] *= alpha; }
    }
    float ps = 0.f;
#pragma unroll
    for (int r = 0; r < 16; ++r) {
      s0[r] = __builtin_amdgcn_exp2f(s0[r] - m); s1[r] = __builtin_amdgcn_exp2f(s1[r] - m); s2[r] = __builtin_amdgcn_exp2f(s2[r] - m); s3[r] = __builtin_amdgcn_exp2f(s3[r] - m);
      ps += (s0[r] + s1[r]) + (s2[r] + s3[r]);
    }
    lsum += ps;
    const lds_cptr vb0 = (lds_cptr)(lds + 36864 + buf * 16384) + vlane;
    const lds_cptr vb1 = vb0 + 8192;
    { const bf16x8 pa = ATT_PACK(s0, 0), pb = ATT_PACK(s1, 0), pc = ATT_PACK(s0, 1), pd = ATT_PACK(s1, 1);
      ATT_PV1(vb0, 0, pa); ATT_PV1(vb0, 32, pb); ATT_PV1(vb0, 16, pc); ATT_PV1(vb0, 48, pd); }
    { const bf16x8 pa = ATT_PACK(s2, 0), pb = ATT_PACK(s3, 0), pc = ATT_PACK(s2, 1), pd = ATT_PACK(s3, 1);
      ATT_PV1(vb1, 0, pa); ATT_PV1(vb1, 32, pb); ATT_PV1(vb1, 16, pc); ATT_PV1(vb1, 48, pd); }
    if (i + 1 < NI) ATT_LWRITE(buf ^ 1);
    __syncthreads();
  }
#undef ATT_GLOAD
#undef ATT_LWRITE
#undef ATT_MASK
#undef ATT_PACK
#undef ATT_PV1
  float lt = lsum + __shfl_xor(lsum, 32);
  float inv;
  if (has_sink) { const float sk = sink * 1.4426950408889634f; const float mf = fmaxf(m, sk); const float sc = __builtin_amdgcn_exp2f(m - mf); inv = sc / (lt * sc + __builtin_amdgcn_exp2f(sk - mf)); }
  else inv = 1.f / lt;
  u16* Op = Qp + (size_t)(wid * 32 + r32) * LDP;
  const u16* Gq = Gp + (size_t)(wid * 32 + r32) * LDP;
  uint2 gg[2][4];
#pragma unroll
  for (int db = 0; db < 2; ++db)
#pragma unroll
    for (int rq = 0; rq < 4; ++rq) gg[db][rq] = *(const uint2*)(Gq + db * 32 + 8 * rq + 4 * hi);
#pragma unroll
  for (int db = 0; db < 2; ++db)
#pragma unroll
    for (int rq = 0; rq < 4; ++rq) {
      const int d = db * 32 + 8 * rq + 4 * hi;
      const uint2 g = gg[db][rq];
      const float v0 = o[db][rq * 4 + 0] * inv * bflo(g.x), v1 = o[db][rq * 4 + 1] * inv * bfhi(g.x);
      const float v2 = o[db][rq * 4 + 2] * inv * bflo(g.y), v3 = o[db][rq * 4 + 3] * inv * bfhi(g.y);
      *(uint2*)(Op + d) = make_uint2(cvtpk(v0, v1), cvtpk(v2, v3));
    }
}

__device__ __forceinline__ void sgu_chunk(const Params& p, int l, int chunk, char* lds, int tid_in) {
  int tid = tid_in; asm volatile("" : "+v"(tid));
  const int lane = tid & 63, wid = tid >> 6, r32 = lane & 31, hi = lane >> 5;
  const int wc = wid >> 2, wp = wid & 3;
  const int R0 = chunk * 128;
  u16* Pr = p.P + (size_t)R0 * LDP;
  float* stt = (float*)(lds + 67584);
#pragma unroll
  for (int half = 0; half < 2; ++half) {
    uint4 raw[8];
#pragma unroll
    for (int rr = 0; rr < 8; ++rr) raw[rr] = *(const uint4*)(Pr + (size_t)(wid * 16 + half * 8 + rr) * LDP + 3072 + lane * 8);
#pragma unroll
    for (int rr = 0; rr < 8; ++rr) {
      const int row = wid * 16 + half * 8 + rr;
      const float x0 = bflo(raw[rr].x), x1 = bfhi(raw[rr].x), x2 = bflo(raw[rr].y), x3 = bfhi(raw[rr].y), x4 = bflo(raw[rr].z), x5 = bfhi(raw[rr].z), x6 = bflo(raw[rr].w), x7 = bfhi(raw[rr].w);
      const float mean = wave_sum(((x0 + x1) + (x2 + x3)) + ((x4 + x5) + (x6 + x7))) * (1.f / 512.f);
      const float d0 = x0 - mean, d1 = x1 - mean, d2 = x2 - mean, d3 = x3 - mean, d4 = x4 - mean, d5 = x5 - mean, d6 = x6 - mean, d7 = x7 - mean;
      const float rstd = rsqrtf(wave_sum(((d0 * d0 + d1 * d1) + (d2 * d2 + d3 * d3)) + ((d4 * d4 + d5 * d5) + (d6 * d6 + d7 * d7))) * (1.f / 512.f) + LN_EPS);
      if (lane == 0) { stt[row * 2] = mean; stt[row * 2 + 1] = rstd; }
    }
  }
  __syncthreads();
  const int ch = tid & 15, row0 = tid >> 4;
  uint4 wr0, wr1, wr2, wr3, vr0, vr1, vr2, vr3; f32x4 g0, g1, b0, b1;
#define SGU_GL1(i_, w_, v_, Wg_, g_) do { w_ = *(const uint4*)((Wg_) + (row0 + 32 * (i_)) * 128 + ch * 8); \
      v_ = *(const uint4*)(Pr + (size_t)(row0 + 32 * (i_)) * LDP + 3072 + (g_) * 128 + ch * 8); } while (0)
#define SGU_GLOAD(g_) do { const u16* Wg_ = p.wsp + (size_t)(l * 4 + (g_)) * 128 * 128; \
    SGU_GL1(0, wr0, vr0, Wg_, g_); SGU_GL1(1, wr1, vr1, Wg_, g_); SGU_GL1(2, wr2, vr2, Wg_, g_); SGU_GL1(3, wr3, vr3, Wg_, g_); \
    const float* gm_ = p.sgu_g + l * 512 + (g_) * 128 + ch * 8; const float* bt_ = p.sgu_b + l * 512 + (g_) * 128 + ch * 8; \
    g0 = *(const f32x4*)gm_; g1 = *(const f32x4*)(gm_ + 4); b0 = *(const f32x4*)bt_; b1 = *(const f32x4*)(bt_ + 4); } while (0)
#define SGU_LW1(i_, w_, v_) do { const int row = row0 + 32 * (i_); \
      *(uint4*)(lds + row * 272 + ch * 16) = w_; \
      const uint4 raw = v_; const float mean = stt[row * 2], rstd = stt[row * 2 + 1]; \
      const float y0 = (bflo(raw.x) - mean) * rstd * g0[0] + b0[0], y1 = (bfhi(raw.x) - mean) * rstd * g0[1] + b0[1]; \
      const float y2 = (bflo(raw.y) - mean) * rstd * g0[2] + b0[2], y3 = (bfhi(raw.y) - mean) * rstd * g0[3] + b0[3]; \
      const float y4 = (bflo(raw.z) - mean) * rstd * g1[0] + b1[0], y5 = (bfhi(raw.z) - mean) * rstd * g1[1] + b1[1]; \
      const float y6 = (bflo(raw.w) - mean) * rstd * g1[2] + b1[2], y7 = (bfhi(raw.w) - mean) * rstd * g1[3] + b1[3]; \
      *(uint4*)(lds + 34816 + (ch >> 2) * 8192 + row * 64 + (ch & 3) * 16) = make_uint4(cvtpk(y0, y1), cvtpk(y2, y3), cvtpk(y4, y5), cvtpk(y6, y7)); } while (0)
#define SGU_LWRITE() do { SGU_LW1(0, wr0, vr0); SGU_LW1(1, wr1, vr1); SGU_LW1(2, wr2, vr2); SGU_LW1(3, wr3, vr3); } while (0)
  SGU_GLOAD(0); SGU_LWRITE();
  __syncthreads();
  const lds_cptr vnb = (lds_cptr)(lds + 34816) + ((lane >> 4) & 1) * 32 + (lane & 3) * 8 + (8 * hi + ((lane & 15) >> 2)) * 64;
  const char* wb = lds + (wp * 32 + r32) * 272 + hi * 16;
  const int prow = wp * 32 + r32;
  u16* rowp = Pr + (size_t)prow * LDP;
#pragma unroll
  for (int g = 0; g < 4; ++g) {
    const int cg0 = g * 128;
    if (g < 3) SGU_GLOAD(g + 1);
    const float bs = p.b_spatial[(l * 4 + g) * 128 + prow];
    uint2 uu[2][4], gq[2][4];
#pragma unroll
    for (int ci = 0; ci < 2; ++ci)
#pragma unroll
      for (int rq = 0; rq < 4; ++rq) { const int c = cg0 + wc * 64 + ci * 32 + 8 * rq + 4 * hi; uu[ci][rq] = *(const uint2*)(rowp + 2560 + c); gq[ci][rq] = *(const uint2*)(rowp + 3584 + c); }
    f32x16 acc[2];
#pragma unroll
    for (int r = 0; r < 16; ++r) { acc[0][r] = 0.f; acc[1][r] = 0.f; }
#pragma unroll
    for (int ks = 0; ks < 8; ++ks) {
      const bf16x8 bfr = *(const bf16x8*)(wb + ks * 32);
#pragma unroll
      for (int ci = 0; ci < 2; ++ci) {
        const lds_cptr vp = vnb + (wc * 2 + ci) * 8192 + ks * 16 * 64;
        const s16x4 lo = vtr(vp), hh = vtr(vp + 256);
        const bf16x8 af = (bf16x8){lo[0], lo[1], lo[2], lo[3], hh[0], hh[1], hh[2], hh[3]};
        acc[ci] = MFMA(af, bfr, acc[ci]);
      }
    }
#pragma unroll
    for (int ci = 0; ci < 2; ++ci)
#pragma unroll
      for (int rq = 0; rq < 4; ++rq) {
        const int c = cg0 + wc * 64 + ci * 32 + 8 * rq + 4 * hi;
        const uint2 u = uu[ci][rq], gg = gq[ci][rq];
        const float v0 = bflo(u.x) * (acc[ci][rq * 4 + 0] + bs) * bflo(gg.x), v1 = bfhi(u.x) * (acc[ci][rq * 4 + 1] + bs) * bfhi(gg.x);
        const float v2 = bflo(u.y) * (acc[ci][rq * 4 + 2] + bs) * bflo(gg.y), v3 = bfhi(u.y) * (acc[ci][rq * 4 + 3] + bs) * bfhi(gg.y);
        *(uint2*)(rowp + 2560 + c) = make_uint2(cvtpk(v0, v1), cvtpk(v2, v3));
      }
    if (g < 3) {
      __syncthreads();
      SGU_LWRITE();
      __syncthreads();
    }
  }
#undef SGU_GL1
#undef SGU_GLOAD
#undef SGU_LW1
#undef SGU_LWRITE
}

__device__ __forceinline__ void phase_p3(const Params& p, int l, char* lds, int wv) {
  const int tid = opaque_tid(wv);
  volatile int* slot = (volatile int*)(lds + LDS_ITEM);
  while (true) {
    __syncthreads();
    if (tid == 0) *slot = atomicAdd(&p.cnt[l], 1);
    __syncthreads();
    const int item0 = *slot;
    if (item0 >= 288 + 864) break;
    if (item0 >= 128 && item0 < 416) {
      SchedGate S{(const char*)p.wt_ig, (const char*)p.H, item0 - 128};
      EpiGate E{p.b_gate, p.G, l};
      int tid2 = tid; asm volatile("" : "+v"(tid2));
      gemm_phase((LAS unsigned char*)lds, 1024, 1024, 1024, S, E, tid2);
      continue;
    }
    const int item = item0 < 128 ? item0 : item0 - 288;
    if (item >= 256 && item < 352) {
      sgu_chunk(p, l, item - 256, lds, tid);
    } else {
      u16* Qp; const u16 *Gp, *K0, *V0, *K1, *V1; int n0, n1, kpos0 = 0, qpos0 = 0; bool masked = false, has_sink = false; float sink = 0.f;
      if (item < 256) {
        const bool isB = item >= 128; const int it = item & 127;
        const int b = it >> 6, head = (it >> 3) & 7, qb = it & 7, kv = head >> 2;
        u16* base = p.P + (size_t)(NCTX + b * 2048) * LDP;
        const size_t coff = ((size_t)(b * 4 + l) * 512) * 128 + kv * 64;
        n1 = 512;
        if (!isB) {
          Qp = base + (size_t)qb * 256 * LDP + head * 64; Gp = base + (size_t)qb * 256 * LDP + 768 + head * 64;
          K0 = base + 512 + kv * 64; V0 = base + 640 + kv * 64; n0 = 2048;
          K1 = p.cachebf + coff; V1 = p.cachebf + 524288 + coff;
        } else {
          const int ks = qb * 256 - 128 < 0 ? 0 : qb * 256 - 128;
          const int ke = qb * 256 + 384 > 2048 ? 2048 : qb * 256 + 384;
          Qp = base + (size_t)qb * 256 * LDP + 1280 + head * 64; Gp = base + (size_t)qb * 256 * LDP + 2048 + head * 64;
          K0 = base + (size_t)ks * LDP + 1792 + kv * 64; V0 = base + (size_t)ks * LDP + 1920 + kv * 64; n0 = ke - ks;
          masked = true; kpos0 = ks; qpos0 = qb * 256;
          K1 = p.cachebf + 2 * 524288 + coff; V1 = p.cachebf + 3 * 524288 + coff;
          has_sink = true; sink = p.sink[l * 8 + head];
        }
      } else {
        const int it0 = item - 352; const bool isB = it0 >= 256; const int it = it0 & 255;
        const int b = it >> 3, head = it & 7, kv = head >> 2;
        u16* base = p.P + (size_t)(b * 256) * LDP;
        n0 = 256; n1 = 0; K1 = base; V1 = base;
        if (!isB) {
          Qp = base + head * 64; Gp = base + 768 + head * 64;
          K0 = base + 512 + kv * 64; V0 = base + 640 + kv * 64;
        } else {
          Qp = base + 1280 + head * 64; Gp = base + 2048 + head * 64;
          K0 = base + 1792 + kv * 64; V0 = base + 1920 + kv * 64;
          has_sink = true; sink = p.sink[l * 8 + head];
        }
      }
      attn_item(Qp, Gp, K0, V0, LDP, n0, masked, kpos0, qpos0, K1, V1, n1 ? 128 : LDP, n1, has_sink, sink, lds, tid);
    }
  }
  __syncthreads();
}

__device__ __forceinline__ void phase_p2(const Params& p, int l, char* lds, int wv) {
  const int tid = opaque_tid(wv);
  SchedP2 S{(const char*)p.wt_ig, (const char*)p.H, (int)gridDim.x, block_id()};
  EpiP2 E{p.b_gate, p.q_norm, p.k_norm, p.rope, p.out + (size_t)NTOK * 1024, p.P, p.G, l};
  gemm_phase((LAS unsigned char*)lds, 1024, 1024, 1024, S, E, tid);
  __syncthreads();
}
__device__ __forceinline__ void phase_p4(const Params& p, int l, char* lds, int wv) {
  const int tid = opaque_tid(wv);
  SchedP4 S{(const char*)p.wt_p, (const char*)p.P, block_id()};
  EpiP4 E{p.G, p.H};
  gemm_phase((LAS unsigned char*)lds, 512, 512, LDP, S, E, tid);
  __syncthreads();
}
__device__ __forceinline__ void phase_p5(const Params& p, int l, char* lds, int wv) {
  const int tid = opaque_tid(wv);
  SchedP5 S{(const char*)p.wt_o, (const char*)p.H, block_id()};
  EpiP5 E{p.mod, p.x_prompt, p.x_sample, p.out, l};
  gemm_phase((LAS unsigned char*)lds, 1024, 1024, 1024, S, E, tid);
  __syncthreads();
}

__device__ __forceinline__ Params load_params() {
#if defined(__HIP_DEVICE_COMPILE__)
  const __attribute__((address_space(4))) char* kp = (const __attribute__((address_space(4))) char*)__builtin_amdgcn_kernarg_segment_ptr();
  asm volatile("" : "+s"(kp));
  return *(const __attribute__((address_space(4))) Params*)kp;
#else
  return Params{};
#endif
}
__device__ __forceinline__ void run_phase(int ph, char* lds, int wv) {
  const Params p = load_params();
  if (ph == 0) { phase_pre(p, lds, wv); return; }
  const int k = ph + 3, l = k / 5 - 1, s = k - (l + 1) * 5;
  if (s == 0) phase_p2(p, l, lds, wv);
  else if (s == 1) phase_p3(p, l, lds, wv);
  else if (s == 2) phase_p4(p, l, lds, wv);
  else if (s == 3) phase_p5(p, l, lds, wv);
  else phase_row(p, l + 1, lds, wv);
}

__global__ void __launch_bounds__(512, 2) fwd_megakernel(Params p, int ph0, int ph1) {
  __shared__ __attribute__((aligned(16))) char lds[LDS_BYTES];
  if (ph1 < 0) cg::this_grid().sync();
  int wv;
  wv = __builtin_amdgcn_readfirstlane((int)(threadIdx.x >> 6));
  run_phase(0, lds, wv);
  hier_barrier(load_params().bar, 0u, wv);
  for (int ph = 1; ph < ph1; ++ph) {
    run_phase(ph, lds, wv);
    if (ph + 1 < ph1) hier_barrier(load_params().bar, (unsigned)ph, wv);
  }
}

extern "C" void kernel_launch(void* const* d_in, const int* in_sizes, int n_in, void* d_out, int out_size, void* d_ws, size_t ws_size, hipStream_t stream) {
  static int grid_blocks = 0;
  if (!grid_blocks) {
    int dev = 0, cus = 0, per_cu = 0;
    (void)hipGetDevice(&dev);
    (void)hipDeviceGetAttribute(&cus, hipDeviceAttributeMultiprocessorCount, dev);
    (void)hipOccupancyMaxActiveBlocksPerMultiprocessor(&per_cu, fwd_megakernel, NTHR, 0);
    if (per_cu < 1) fprintf(stderr, "occupancy query returned %d\n", per_cu);
    grid_blocks = cus;
  }
  Params p{};
  p.x_prompt = (const float*)d_in[0]; p.x_sample = (const float*)d_in[1];
  p.cache0 = (const float*)d_in[2]; p.cache1 = (const float*)d_in[3]; p.cache2 = (const float*)d_in[4]; p.cache3 = (const float*)d_in[5];
  p.c = (const float*)d_in[6]; p.c_ctx = (const float*)d_in[7];
  p.w_mod = (const float*)d_in[8]; p.b_mod = (const float*)d_in[9]; p.w_in = (const float*)d_in[10];
  p.q_norm = (const float*)d_in[11]; p.k_norm = (const float*)d_in[12]; p.sink = (const float*)d_in[13];
  p.sgu_g = (const float*)d_in[14]; p.sgu_b = (const float*)d_in[15]; p.w_spatial = (const float*)d_in[16]; p.b_spatial = (const float*)d_in[17];
  p.w_proj0 = (const float*)d_in[18]; p.w_proj1 = (const float*)d_in[19]; p.w_proj2 = (const float*)d_in[20];
  p.w_gate = (const float*)d_in[21]; p.b_gate = (const float*)d_in[22]; p.w_out = (const float*)d_in[23];
  p.ln_g = (const float*)d_in[24]; p.ln_b = (const float*)d_in[25];
  p.out = (float*)d_out;
  char* w = (char*)d_ws; size_t off = 0;
  auto take = [&](size_t bytes) { char* r = w + off; off += (bytes + 255) & ~(size_t)255; return r; };
  p.mod = (float*)take(4 * 3 * 3072 * 4);
  p.rope = (float*)take(2048 * 4);
  p.bar = (unsigned*)take(XCD_BAR_WORDS * 4);
  p.cnt = (int*)take(1024);
  p.wsp = (u16*)take(262144 * 2);
  p.cachebf = (u16*)take((size_t)4 * 524288 * 2);
  p.wt_ig = (u16*)take((size_t)7168 * 1024 * 2);
  p.wt_p = (u16*)take((size_t)3 * 1024 * 512 * 2);
  p.wt_o = (u16*)take((size_t)1024 * 1024 * 2);
  p.H = (u16*)take((size_t)NTOK * 1024 * 2);
  p.P = (u16*)take((size_t)NTOK * LDP * 2);
  p.G = (u16*)take((size_t)NTOK * 3072 * 2);
  if (off > ws_size) { fprintf(stderr, "workspace too small: need %zu have %zu\n", off, ws_size); return; }
  (void)hipMemsetAsync(p.bar, 0, XCD_BAR_WORDS * 4 + 1024, stream);
  int ph0 = 0, ph1 = 22;
  void* args[] = {&p, &ph0, &ph1};
  hipError_t e = hipLaunchCooperativeKernel((void*)fwd_megakernel, dim3(grid_blocks), dim3(NTHR), args, 0, stream);
  if (e != hipSuccess) fprintf(stderr, "cooperative launch failed: %s (grid %d)\n", hipGetErrorString(e), grid_blocks);
}
```

```cpp
#include <hip/hip_runtime.h>
#include <hip/hip_cooperative_groups.h>
#include <cstdio>
#include <cstdint>
namespace cg = cooperative_groups;

#ifndef COOP
#define COOP 1
#endif

typedef unsigned short u16;
using bf16x8 = __attribute__((ext_vector_type(8))) short;
using s16x4 = __attribute__((ext_vector_type(4))) short;
using f32x16 = __attribute__((ext_vector_type(16))) float;
using f32x4 = __attribute__((ext_vector_type(4))) float;
typedef float f32x4_t __attribute__((ext_vector_type(4)));
typedef short v4i16_t __attribute__((ext_vector_type(4)));
typedef __attribute__((address_space(3))) const char* lds_cptr;

#define MFMA(a, b, c) __builtin_amdgcn_mfma_f32_32x32x16_bf16(a, b, c, 0, 0, 0)

constexpr int NTOK = 12288, NCTX = 8192;
constexpr int NTHR = 512, NWAVE = 8;
constexpr int LDP = 4096 + 128;
constexpr int LDS_BYTES = 131072 + 64;
constexpr int LDS_ITEM = 131072;
constexpr float ALPHA = 1.681792830507429f;
constexpr float LN_EPS = 1e-6f;

struct Params {
  const float* x_prompt; const float* x_sample; const float* cache0; const float* cache1; const float* cache2; const float* cache3; const float* c; const float* c_ctx;
  const float* w_mod; const float* b_mod; const float* w_in; const float* q_norm; const float* k_norm; const float* sink;
  const float* sgu_g; const float* sgu_b; const float* w_spatial; const float* b_spatial;
  const float* w_proj0; const float* w_proj1; const float* w_proj2; const float* w_gate; const float* b_gate; const float* w_out; const float* ln_g; const float* ln_b;
  float* out;
  float* mod; float* rope; unsigned* bar; int* cnt; u16* wsp; u16* cachebf; u16* wt_ig; u16* wt_p; u16* wt_o; u16* H; u16* P; u16* G;
};

__device__ __forceinline__ unsigned cvtpk(float lo, float hi) { unsigned r; asm("v_cvt_pk_bf16_f32 %0, %1, %2" : "=v"(r) : "v"(lo), "v"(hi)); return r; }
__device__ __forceinline__ float bflo(unsigned u) { return __uint_as_float(u << 16); }
__device__ __forceinline__ float bfhi(unsigned u) { return __uint_as_float(u & 0xffff0000u); }
__device__ __forceinline__ int crow(int r, int hi) { return (r & 3) + 8 * (r >> 2) + 4 * hi; }
__device__ __forceinline__ float silu_f(float x) { return x * __builtin_amdgcn_rcpf(1.f + __builtin_amdgcn_exp2f(-1.4426950408889634f * x)); }
__device__ __forceinline__ float sigmoid_f(float x) { return __builtin_amdgcn_rcpf(1.f + __builtin_amdgcn_exp2f(-1.4426950408889634f * x)); }
__device__ __forceinline__ s16x4 vtr(lds_cptr p) { return __builtin_bit_cast(s16x4, __builtin_amdgcn_ds_read_tr16_b64_v4i16((__attribute__((address_space(3))) v4i16_t*)p)); }
__device__ __forceinline__ int block_id() { int b = (int)blockIdx.x; asm volatile("" : "+s"(b)); return b; }
__device__ __forceinline__ int lane_id() { unsigned z = 0u; asm volatile("" : "+s"(z)); return (int)__builtin_amdgcn_mbcnt_hi(~0u, __builtin_amdgcn_mbcnt_lo(~0u, z)); }
__device__ __forceinline__ int opaque_tid(int wv) { asm volatile("" : "+s"(wv)); int t = wv * 64 + lane_id(); asm volatile("" : "+v"(t)); return t; }
__device__ __forceinline__ float wave_sum(float v) {
#pragma unroll
  for (int o = 32; o > 0; o >>= 1) v += __shfl_xor(v, o);
  return v;
}


#define XB_TMO      128
#define XB_XCNT(j)  (256  + 64 * (j))
#define XB_XSUB(j)  (1280 + 64 * (j))
#define XB_XGEN(j)  (2304 + 64 * (j))
#define XB_TOP      3328
#define XB_TOPGEN   3392
#define XCD_BAR_WORDS 3456
#define XB_SPIN_CAP (1u << 18)
#define LAS __attribute__((address_space(3)))
__device__ __forceinline__ unsigned xb_ld(unsigned* p)              { return __hip_atomic_load(p, __ATOMIC_RELAXED, __HIP_MEMORY_SCOPE_AGENT); }
__device__ __forceinline__ unsigned xb_add(unsigned* p, unsigned v) { return __hip_atomic_fetch_add(p, v, __ATOMIC_RELAXED, __HIP_MEMORY_SCOPE_AGENT); }
__device__ __forceinline__ unsigned xb_xcc_id() { return (unsigned)__builtin_amdgcn_s_getreg((3 << 11) | 20) & 0xFu; }
#define XB_SPIN(cond, bar) do { unsigned _sp = 0; while (cond) { __builtin_amdgcn_s_sleep(1); \
    if ((++_sp & 255u) == 0u) { if (xb_ld(&(bar)[XB_TMO])) break; if (_sp > XB_SPIN_CAP) { atomicAdd(&(bar)[XB_TMO], 1u); break; } } } } while (0)
struct XcdBarrier { unsigned* bar; unsigned x; volatile LAS unsigned* st; };
__device__ __forceinline__ XcdBarrier xcd_barrier_post(unsigned* bar, volatile LAS unsigned* st) {
    XcdBarrier b; b.bar = bar; b.x = xb_xcc_id(); b.st = st;
    if (threadIdx.x == 0) (void)xb_add(&bar[XB_XCNT(b.x)], 1u);
    return b;
}
__device__ __forceinline__ void xcd_barrier_complete(unsigned* bar, unsigned x, unsigned& nloc, unsigned& nx) {
    const unsigned G = gridDim.x * gridDim.y * gridDim.z;
    unsigned sum, cnt, mine, sp = 0u;
    for (;;) {
        sum = 0u; cnt = 0u; mine = 0u;
#pragma unroll
        for (unsigned j = 0; j < 16; ++j) { const unsigned c = xb_ld(&bar[XB_XCNT(j)]); sum += c; cnt += (c > 0u) ? 1u : 0u; mine = (j == x) ? c : mine; }
        if (sum == G) break;
        __builtin_amdgcn_s_sleep(1);
        if ((++sp & 255u) == 0u) { if (xb_ld(&bar[XB_TMO])) break; if (sp > XB_SPIN_CAP) { atomicAdd(&bar[XB_TMO], 1u); break; } }
    }
    nloc = mine > 0u ? mine : 1u; nx = cnt > 0u ? cnt : 1u;
}
__device__ __forceinline__ void xcd_barrier(const XcdBarrier& b) {
    asm volatile("s_waitcnt vmcnt(0)" ::: "memory");
    __syncthreads();
    if (threadIdx.x == 0) {
        unsigned* bar = b.bar;
        __builtin_amdgcn_s_waitcnt(0);
        unsigned nloc = b.st[0], nx = b.st[1];
        if (nloc == 0u) { xcd_barrier_complete(bar, b.x, nloc, nx); b.st[0] = nloc; b.st[1] = nx; }
        const unsigned old = xb_add(&bar[XB_XSUB(b.x)], 1u);
        const unsigned gen = old / nloc;
        if (old + 1u == (gen + 1u) * nloc) {
            __builtin_amdgcn_fence(__ATOMIC_RELEASE, "agent");
            asm volatile("s_waitcnt vmcnt(0)" ::: "memory");
            const unsigned og = xb_add(&bar[XB_TOP], 1u);
            const unsigned tg = og / nx;
            if (og + 1u == (tg + 1u) * nx) xb_add(&bar[XB_TOPGEN], 1u);
            else XB_SPIN(xb_ld(&bar[XB_TOPGEN]) == tg, bar);
            __builtin_amdgcn_fence(__ATOMIC_ACQUIRE, "agent");
            xb_add(&bar[XB_XGEN(b.x)], 1u);
            asm volatile("s_waitcnt vmcnt(0)" ::: "memory");
        } else {
            XB_SPIN(xb_ld(&bar[XB_XGEN(b.x)]) == gen, bar);
            __builtin_amdgcn_fence(__ATOMIC_ACQUIRE, "agent");
            asm volatile("s_waitcnt vmcnt(0)" ::: "memory");
        }
    }
    __syncthreads();
}

__device__ __forceinline__ void hier_barrier(unsigned* bar, unsigned round, int wv) {
    asm volatile("s_waitcnt vmcnt(0)" ::: "memory");
    __syncthreads();
    if (wv == 0 && lane_id() == 0) {
        const unsigned G = gridDim.x, grp = blockIdx.x & 7u;
        const unsigned nloc = (G - grp + 7u) >> 3, nx = G < 8u ? G : 8u;
        __builtin_amdgcn_fence(__ATOMIC_RELEASE, "agent");
        asm volatile("s_waitcnt vmcnt(0)" ::: "memory");
        const unsigned old = xb_add(&bar[XB_XSUB(grp)], 1u);
        const unsigned gen = round;
        if (old + 1u == (gen + 1u) * nloc) {
            const unsigned og = xb_add(&bar[XB_TOP], 1u);
            const unsigned tg = round;
            if (og + 1u == (tg + 1u) * nx) xb_add(&bar[XB_TOPGEN], 1u);
            else while (xb_ld(&bar[XB_TOPGEN]) == tg) __builtin_amdgcn_s_sleep(1);
        } else {
            while (xb_ld(&bar[XB_TOPGEN]) == gen) __builtin_amdgcn_s_sleep(1);
        }
        __builtin_amdgcn_fence(__ATOMIC_ACQUIRE, "agent");
        asm volatile("s_waitcnt vmcnt(0)" ::: "memory");
    }
    __syncthreads();
}
__device__ __forceinline__ void simple_barrier(unsigned* cnt, unsigned target) {
    asm volatile("s_waitcnt vmcnt(0)" ::: "memory");
    __syncthreads();
    if (threadIdx.x == 0) {
        __builtin_amdgcn_fence(__ATOMIC_RELEASE, "agent");
        asm volatile("s_waitcnt vmcnt(0)" ::: "memory");
        xb_add(cnt, 1u);
        while (xb_ld(cnt) < target) __builtin_amdgcn_s_sleep(1);
        __builtin_amdgcn_fence(__ATOMIC_ACQUIRE, "agent");
        asm volatile("s_waitcnt vmcnt(0)" ::: "memory");
    }
    __syncthreads();
}

struct ConvTile { const float* src; u16* dst; int N, K; };
__device__ __forceinline__ ConvTile conv_desc(const Params& p, int l, int t, const float* wp0, const float* wp1, const float* wp2) {
  ConvTile c;
  if (t < 1024) { c.src = p.w_in + (size_t)l * 1024 * 4096 + (size_t)((t >> 6) * 64) * 4096 + (t & 63) * 64; c.N = 4096; c.K = 1024; c.dst = p.wt_ig + (size_t)((t & 63) * 64) * 1024 + (t >> 6) * 64; }
  else if (t < 1792) { const int u = t - 1024; const int kt = u / 48, nt = u % 48; c.src = p.w_gate + (size_t)l * 1024 * 3072 + (size_t)(kt * 64) * 3072 + nt * 64; c.N = 3072; c.K = 1024; c.dst = p.wt_ig + (size_t)(4096 + nt * 64) * 1024 + kt * 64; }
  else if (t < 2176) { const int u = t - 1792; const int b = u >> 7, r = u & 127; const int kt = r >> 4, nt = r & 15;
    c.src = (b == 0 ? wp0 : (b == 1 ? wp1 : wp2)) + (size_t)l * 512 * 1024 + (size_t)(kt * 64) * 1024 + nt * 64; c.N = 1024; c.K = 512; c.dst = p.wt_p + ((size_t)b * 1024 + nt * 64) * 512 + kt * 64; }
  else { const int u = t - 2176; const int kt = u >> 4, nt = u & 15; c.src = p.w_out + (size_t)l * 1024 * 1024 + (size_t)(kt * 64) * 1024 + nt * 64; c.N = 1024; c.K = 1024; c.dst = p.wt_o + (size_t)(nt * 64) * 1024 + kt * 64; }
  return c;
}
__device__ __forceinline__ void conv_weights(const Params& p, int l, char* lds, int tid) {
  const float* wp0 = p.w_proj0; const float* wp1 = p.w_proj1; const float* wp2 = p.w_proj2;
  float* tile = (float*)lds;
  const int kk0 = tid >> 4, cc = (tid & 15) * 4;
  const int n = tid >> 3, kc = (tid & 7) * 8;
  int t = blockIdx.x;
  float4 v0 = make_float4(0.f, 0.f, 0.f, 0.f), v1 = v0; ConvTile c = conv_desc(p, l, t < 2432 ? t : 0, wp0, wp1, wp2);
  if (t < 2432) { v0 = *(const float4*)(c.src + (size_t)kk0 * c.N + cc); v1 = *(const float4*)(c.src + (size_t)(kk0 + 32) * c.N + cc); }
  while (t < 2432) {
    const int tn = t + gridDim.x;
    const ConvTile cn = conv_desc(p, l, tn < 2432 ? tn : 0, wp0, wp1, wp2);
    float4 n0 = v0, n1 = v1;
    if (tn < 2432) { n0 = *(const float4*)(cn.src + (size_t)kk0 * cn.N + cc); n1 = *(const float4*)(cn.src + (size_t)(kk0 + 32) * cn.N + cc); }
    __syncthreads();
    { float* tp = tile + kk0 * 65 + cc; tp[0] = v0.x; tp[1] = v0.y; tp[2] = v0.z; tp[3] = v0.w;
      float* tq = tile + (kk0 + 32) * 65 + cc; tq[0] = v1.x; tq[1] = v1.y; tq[2] = v1.z; tq[3] = v1.w; }
    __syncthreads();
    const unsigned w0 = cvtpk(tile[(kc + 0) * 65 + n], tile[(kc + 1) * 65 + n]), w1 = cvtpk(tile[(kc + 2) * 65 + n], tile[(kc + 3) * 65 + n]);
    const unsigned w2 = cvtpk(tile[(kc + 4) * 65 + n], tile[(kc + 5) * 65 + n]), w3 = cvtpk(tile[(kc + 6) * 65 + n], tile[(kc + 7) * 65 + n]);
    *(uint4*)(c.dst + (size_t)n * c.K + kc) = make_uint4(w0, w1, w2, w3);
    v0 = n0; v1 = n1; c = cn; t = tn;
  }
  __syncthreads();
}

__device__ __forceinline__ void phase_pre(const Params& p, char* lds, int wv) {
  const int tid = opaque_tid(wv), lane = tid & 63, wid = tid >> 6;
  const int gtid = blockIdx.x * NTHR + tid, gsz = gridDim.x * NTHR;
  for (int i = gtid; i < 1024; i += gsz) {
    const int pos = i >> 4, f = i & 15;
    const float inv = exp2f(-(float)f * 0.8304820237218406f);
    const float a = (float)pos * inv;
    p.rope[i] = __cosf(a); p.rope[1024 + i] = __sinf(a);
  }
  const float* c0 = p.cache0; const float* c1 = p.cache1; const float* c2 = p.cache2; const float* c3 = p.cache3;
  for (int i = gtid; i < 4 * 65536; i += gsz) {
    const int t = i >> 16; const int o = (i & 65535) * 8;
    const float* cs = t == 0 ? c0 : (t == 1 ? c1 : (t == 2 ? c2 : c3));
    const float4* s = (const float4*)(cs + o); const float4 a = s[0], b = s[1];
    *(uint4*)(p.cachebf + (size_t)t * 524288 + o) = make_uint4(cvtpk(a.x, a.y), cvtpk(a.z, a.w), cvtpk(b.x, b.y), cvtpk(b.z, b.w));
  }
  for (int i = gtid; i < 32768; i += gsz) {
    const float4* s = (const float4*)(p.w_spatial + (size_t)i * 8); const float4 a = s[0], b = s[1];
    *(uint4*)(p.wsp + (size_t)i * 8) = make_uint4(cvtpk(a.x, a.y), cvtpk(a.z, a.w), cvtpk(b.x, b.y), cvtpk(b.z, b.w));
  }
  float* red = (float*)lds;
  for (int task = blockIdx.x; task < 192; task += gridDim.x) {
    const int l = task / 48, n0 = (task % 48) * 64;
    const float* W = p.w_mod + (size_t)l * 1024 * 3072 + n0 + lane;
    float a0 = 0.f, a1 = 0.f, a2 = 0.f;
#pragma unroll 16
    for (int k = wid * 128; k < wid * 128 + 128; ++k) {
      const float w = W[(size_t)k * 3072];
      a0 += silu_f(p.c[k]) * w; a1 += silu_f(p.c[1024 + k]) * w; a2 += silu_f(p.c_ctx[k]) * w;
    }
    __syncthreads();
    red[(wid * 3 + 0) * 64 + lane] = a0; red[(wid * 3 + 1) * 64 + lane] = a1; red[(wid * 3 + 2) * 64 + lane] = a2;
    __syncthreads();
    if (wid < 3) {
      float s = 0.f;
#pragma unroll
      for (int w = 0; w < 8; ++w) s += red[(w * 3 + wid) * 64 + lane];
      p.mod[(l * 3 + wid) * 3072 + n0 + lane] = s + p.b_mod[l * 3072 + n0 + lane];
    }
  }
  conv_weights(p, 0, lds, tid);
}

__device__ __forceinline__ void phase_row(const Params& p, int l, char* lds, int wv) {
  const int tid = opaque_tid(wv), lane = tid & 63, wid = tid >> 6;
  const int rstride = gridDim.x * NWAVE;
  for (int row0 = blockIdx.x * NWAVE + wid; row0 < NTOK; row0 += 2 * rstride) {
    f32x4 v[2][4];
#pragma unroll
    for (int u = 0; u < 2; ++u) {
      const int row = row0 + u * rstride;
      if (row < NTOK) {
        const float* src = (l == 0) ? (row < NCTX ? p.x_prompt + (size_t)row * 1024 : p.x_sample + (size_t)(row - NCTX) * 1024) : p.out + (size_t)row * 1024;
#pragma unroll
        for (int j = 0; j < 4; ++j) v[u][j] = *(const f32x4*)(src + j * 256 + lane * 4);
      }
    }
#pragma unroll
    for (int u = 0; u < 2; ++u) {
      const int row = row0 + u * rstride;
      if (row < NTOK) {
        if (l > 0) {
          float s = 0.f;
#pragma unroll
          for (int j = 0; j < 4; ++j) s += v[u][j][0] + v[u][j][1] + v[u][j][2] + v[u][j][3];
          const float mean = wave_sum(s) * (1.f / 1024.f);
          float q = 0.f;
#pragma unroll
          for (int j = 0; j < 4; ++j) { v[u][j] -= mean; q += v[u][j][0] * v[u][j][0] + v[u][j][1] * v[u][j][1] + v[u][j][2] * v[u][j][2] + v[u][j][3] * v[u][j][3]; }
          const float rstd = rsqrtf(wave_sum(q) * (1.f / 1024.f) + LN_EPS);
#pragma unroll
          for (int j = 0; j < 4; ++j) {
            const f32x4 g = *(const f32x4*)(p.ln_g + (l - 1) * 1024 + j * 256 + lane * 4), b = *(const f32x4*)(p.ln_b + (l - 1) * 1024 + j * 256 + lane * 4);
            v[u][j] = v[u][j] * rstd * g + b;
            *(f32x4*)(p.out + (size_t)row * 1024 + j * 256 + lane * 4) = v[u][j];
          }
        }
        if (l < 4) {
          float s = 0.f;
#pragma unroll
          for (int j = 0; j < 4; ++j) s += v[u][j][0] + v[u][j][1] + v[u][j][2] + v[u][j][3];
          const float mean = wave_sum(s) * (1.f / 1024.f);
          float q = 0.f;
#pragma unroll
          for (int j = 0; j < 4; ++j) { v[u][j] -= mean; q += v[u][j][0] * v[u][j][0] + v[u][j][1] * v[u][j][1] + v[u][j][2] * v[u][j][2] + v[u][j][3] * v[u][j][3]; }
          const float rstd = rsqrtf(wave_sum(q) * (1.f / 1024.f) + LN_EPS);
          const int mv = row < NCTX ? 2 : ((row - NCTX) >> 11);
          const float* md = p.mod + (l * 3 + mv) * 3072;
#pragma unroll
          for (int j = 0; j < 4; ++j) {
            const f32x4 sh = *(const f32x4*)(md + j * 256 + lane * 4), sc = *(const f32x4*)(md + 1024 + j * 256 + lane * 4);
            const f32x4 h = v[u][j] * rstd * (1.f + sc) + sh;
            *(uint2*)(p.H + (size_t)row * 1024 + j * 256 + lane * 4) = make_uint2(cvtpk(h[0], h[1]), cvtpk(h[2], h[3]));
          }
        }
      }
    }
  }
  if (l > 0 && l < 4) conv_weights(p, l, lds, tid);
}

constexpr int G_BK = 64, G_HALF = 128, G_HTB = G_HALF * G_BK * 2;
__device__ __forceinline__ int lds_byte(int r, int c) { const int st = (r >> 4) * 2 + (c >> 5), rr = r & 15, cc = c & 31, ob = rr * 64 + cc * 2; return st * 1024 + (ob ^ (((ob >> 9) & 1) << 5)); }
__device__ __forceinline__ void stage_rc(int b, int& R, int& C) { const int st = b / 1024, sb = b % 1024, swz = sb ^ (((sb >> 9) & 1) << 5); R = (st >> 1) * 16 + swz / 64; C = (st & 1) * 32 + (swz % 64) / 2; }
struct Unit { const char* a; const char* b; int pm, pn, aux; };

template <class Epi, class Sched>
__device__ __forceinline__ void gemm_phase(LAS unsigned char* lds, const int K, const int lda, const int ldb, const Sched& S, const Epi& E, const int tid) {
    const int wid = __builtin_amdgcn_readfirstlane(tid >> 6), lane = tid & 63, wr = wid >> 2, wc = wid & 3, fr = lane & 15, fq = lane >> 4;
    const int nt = K / G_BK;
    unsigned voffA[2], voffB[2];
#pragma unroll
    for (int i = 0; i < 2; ++i) { int R, C; stage_rc(tid * 16 + i * 8192, R, C); const int rho = R & 63, Ra = (R & ~63) + 32 * (rho >> 5) + 8 * ((rho >> 2) & 3) + 4 * ((rho >> 4) & 1) + (rho & 3);
        voffA[i] = (unsigned)(Ra * lda + C) * 2u; voffB[i] = (unsigned)(R * ldb + C) * 2u; }
    const size_t kstep = (size_t)(G_BK * 2);
    const size_t hstepA = (size_t)G_HALF * lda * 2, hstepB = (size_t)G_HALF * ldb * 2;
    const unsigned ldsw = (unsigned)wid * 1024u;
    const int aoff = lds_byte(wr * 64 + fr, fq * 8), boff = lds_byte(wc * 32 + fr, fq * 8);
#define PG8_SA(b, h) (((b) * 2 + (h)) * G_HTB)
#define PG8_SB(b, h) ((4 + (b) * 2 + (h)) * G_HTB)
#define PG8_STAGE(bufoff, gbase, voff) do { _Pragma("unroll") for (int _i = 0; _i < 2; ++_i) \
        __builtin_amdgcn_global_load_lds((const unsigned*)((const char*)(gbase) + (voff)[_i]), (LAS unsigned*)(lds + (bufoff) + ldsw + _i * 8192), 16, 0, 0); } while (0)
#define PG8_LDA(dst, b, h) do { _Pragma("unroll") for (int m = 0; m < 4; ++m) _Pragma("unroll") for (int k = 0; k < 2; ++k) dst[m][k] = *(const LAS bf16x8*)(lds + PG8_SA(b, h) + aoff + m * 2048 + k * 1024); } while (0)
#define PG8_LDB(dst, b, h) do { _Pragma("unroll") for (int n = 0; n < 2; ++n) _Pragma("unroll") for (int k = 0; k < 2; ++k) dst[n][k] = *(const LAS bf16x8*)(lds + PG8_SB(b, h) + boff + n * 2048 + k * 1024); } while (0)
#define PG8_MMA(ai, bj, At, Bt) do { __builtin_amdgcn_s_setprio(1); _Pragma("unroll") for (int m = 0; m < 4; ++m) _Pragma("unroll") for (int n = 0; n < 2; ++n) _Pragma("unroll") for (int k = 0; k < 2; ++k) \
        acc[ai][bj][m][n] = __builtin_amdgcn_mfma_f32_16x16x32_bf16(At[m][k], Bt[n][k], acc[ai][bj][m][n], 0, 0, 0); __builtin_amdgcn_s_setprio(0); } while (0)
#define PG8_WAIT_V(n) asm volatile("s_waitcnt vmcnt(" #n ")" ::: "memory")
#define PG8_WAIT_L(n) asm volatile("s_waitcnt lgkmcnt(" #n ")" ::: "memory")
#define PG8_BAR __builtin_amdgcn_s_barrier()
#define PG8_SCHED __builtin_amdgcn_sched_barrier(0)
    Unit cur, nxt; int ui = 0;
    if (!S.next(0, cur)) return;
    f32x4_t acc[2][2][4][2];
#pragma unroll
    for (int a = 0; a < 2; ++a)
#pragma unroll
        for (int b = 0; b < 2; ++b)
#pragma unroll
            for (int m = 0; m < 4; ++m)
#pragma unroll
                for (int n = 0; n < 2; ++n) acc[a][b][m][n] = (f32x4_t){0.f, 0.f, 0.f, 0.f};
    bf16x8 At[4][2], B0[2][2], B1[2][2];
    const char* cA = cur.a; const char* cB = cur.b;
    PG8_STAGE(PG8_SB(0, 0), cB, voffB); PG8_STAGE(PG8_SA(0, 0), cA, voffA); PG8_STAGE(PG8_SB(0, 1), cB + hstepB, voffB); PG8_STAGE(PG8_SA(0, 1), cA + hstepA, voffA);
    if (wr == 1) PG8_BAR;
    PG8_WAIT_V(4); PG8_BAR;
    PG8_STAGE(PG8_SB(1, 0), cB + kstep, voffB); PG8_STAGE(PG8_SA(1, 0), cA + kstep, voffA); PG8_STAGE(PG8_SB(1, 1), cB + hstepB + kstep, voffB);
    PG8_WAIT_V(6); PG8_BAR;
    for (;;) {
        const bool has_next = S.next(ui + 1, nxt);
        const char* nA = has_next ? nxt.a : cA; const char* nB = has_next ? nxt.b : cB;
        for (int t = 0; t < nt; t += 2) {
            const bool last = (t == nt - 2);
            const char* a1 = cA + (size_t)(t + 1) * kstep;
            const char* a2 = last ? nA : cA + (size_t)(t + 2) * kstep; const char* b2 = last ? nB : cB + (size_t)(t + 2) * kstep;
            const char* a3 = a2 + kstep; const char* b3 = b2 + kstep;
            PG8_LDB(B0, 0, 0); PG8_SCHED; PG8_LDA(At, 0, 0); PG8_STAGE(PG8_SA(1, 1), a1 + hstepA, voffA);
            PG8_WAIT_L(8); PG8_BAR; PG8_WAIT_L(0); PG8_MMA(0, 0, At, B0); PG8_BAR; PG8_SCHED;
            PG8_LDB(B1, 0, 1); PG8_STAGE(PG8_SB(0, 0), b2, voffB);
            PG8_BAR; PG8_WAIT_L(0); PG8_MMA(0, 1, At, B1); PG8_BAR;
            PG8_LDA(At, 0, 1); PG8_STAGE(PG8_SA(0, 0), a2, voffA);
            PG8_BAR; PG8_WAIT_L(0); PG8_MMA(1, 0, At, B0); PG8_BAR; PG8_SCHED;
            PG8_STAGE(PG8_SB(0, 1), b2 + hstepB, voffB);
            PG8_WAIT_V(6); PG8_BAR; PG8_MMA(1, 1, At, B1); PG8_BAR;
            PG8_LDB(B0, 1, 0); PG8_SCHED; PG8_LDA(At, 1, 0); PG8_STAGE(PG8_SA(0, 1), a2 + hstepA, voffA);
            PG8_WAIT_L(8); PG8_BAR; PG8_WAIT_L(0); PG8_MMA(0, 0, At, B0); PG8_BAR; PG8_SCHED;
            PG8_LDB(B1, 1, 1); PG8_STAGE(PG8_SB(1, 0), b3, voffB);
            PG8_BAR; PG8_WAIT_L(0); PG8_MMA(0, 1, At, B1); PG8_BAR;
            PG8_LDA(At, 1, 1); PG8_STAGE(PG8_SA(1, 0), a3, voffA);
            PG8_BAR; PG8_WAIT_L(0); PG8_MMA(1, 0, At, B0); PG8_BAR; PG8_SCHED;
            PG8_STAGE(PG8_SB(1, 1), b3 + hstepB, voffB);
            PG8_WAIT_V(6); PG8_BAR; PG8_MMA(1, 1, At, B1); PG8_BAR;
        }
        E(acc, cur, wid, wr, wc, fr, fq, lane);
        if (!has_next) break;
        if (!E.keep_acc(cur)) {
#pragma unroll
        for (int a = 0; a < 2; ++a)
#pragma unroll
            for (int b = 0; b < 2; ++b)
#pragma unroll
                for (int m = 0; m < 4; ++m)
#pragma unroll
                    for (int n = 0; n < 2; ++n) acc[a][b][m][n] = (f32x4_t){0.f, 0.f, 0.f, 0.f};
        }
        cur = nxt; cA = nA; cB = nB; ++ui;
    }
    PG8_WAIT_V(0);
    if (wr == 0) PG8_BAR;
    PG8_BAR;
#undef PG8_SA
#undef PG8_SB
#undef PG8_STAGE
#undef PG8_LDA
#undef PG8_LDB
#undef PG8_MMA
#undef PG8_WAIT_V
#undef PG8_WAIT_L
#undef PG8_BAR
#undef PG8_SCHED
}

__device__ __forceinline__ void tile_of(int L, int nM, int nN, int& pm, int& pn) {
  const int nwg = nM * nN;
  int wgid = L; { const int q = nwg / 8, r = nwg % 8, xcd = wgid % 8, off = wgid / 8; wgid = (xcd < r ? xcd * (q + 1) : r * (q + 1) + (xcd - r) * q) + off; }
  const int nig = 8 * nN, gid = wgid / nig, fm = gid * 8, gsz = (nM - fm) < 8 ? (nM - fm) : 8;
  pm = fm + ((wgid % nig) % gsz); pn = (wgid % nig) / gsz;
}

struct SchedP2 {
  const char* A; const char* B; int G, c;
  __device__ __forceinline__ bool next(int i, Unit& u) const {
    const int L = i * G + c; if (L >= 16 * 48) return false;
    tile_of(L, 16, 48, u.pm, u.pn); u.aux = 0;
    u.pm = (u.pm & 1) * 8 + (u.pm >> 1);
    u.pn = (u.pn & 3) * 12 + (u.pn >> 2);
    u.a = A + (size_t)u.pm * 256 * 1024 * 2; u.b = B + (size_t)u.pn * 256 * 1024 * 2; return true;
  }
};
struct EpiP2 {
  __device__ __forceinline__ bool keep_acc(const Unit&) const { return false; }
  const float* b_gate; const float* q_norm; const float* k_norm; const float* rope; float* so; u16* P; u16* G; int l;
  __device__ __forceinline__ void operator()(f32x4_t (&acc)[2][2][4][2], const Unit& u, int wid, int wr, int wc, int fr, int fq, int lane) const {
    const int f0 = u.pm * 256, t0 = u.pn * 256;
    const bool lat = t0 >= NCTX;
#pragma unroll
    for (int ai = 0; ai < 2; ++ai) {
      const int fb = f0 + 128 * ai + 64 * wr;
      int norm = 0, kvh = 0; bool rp = false, act = false; float scl = 1.f; float* st = nullptr;
      if (fb < 512) { norm = 1; rp = lat; scl = 0.18033688011112042f; }
      else if (fb < 640) { norm = 2; rp = lat; kvh = (fb - 512) >> 6; if (!lat) st = so; }
      else if (fb < 768) { kvh = (fb - 640) >> 6; if (!lat) st = so + 4194304; }
      else if (fb < 1280) { act = true; }
      else if (fb < 1792) { rp = lat; scl = 0.18033688011112042f; }
      else if (fb < 1920) { rp = lat; kvh = (fb - 1792) >> 6; if (!lat) st = so + 2 * 4194304; }
      else if (fb < 2048) { kvh = (fb - 1920) >> 6; if (!lat) st = so + 3 * 4194304; }
      else if (fb < 2560) { act = true; }
      else if (fb < 3584) { }
      else { act = true; }
      if (norm) {
        f32x4_t gn[4];
#pragma unroll
        for (int m = 0; m < 4; ++m) {
          const int dd = 32 * (m >> 1) + 8 * fq + 4 * (m & 1);
          const f32x4_t gq = *(const f32x4_t*)(q_norm + l * 64 + dd), gk = *(const f32x4_t*)(k_norm + l * 64 + dd);
          gn[m] = norm == 1 ? gq : gk;
        }
#pragma unroll
        for (int bj = 0; bj < 2; ++bj)
#pragma unroll
          for (int n = 0; n < 2; ++n) {
            float ss = 0.f;
#pragma unroll
            for (int m = 0; m < 4; ++m) { const f32x4_t x = acc[ai][bj][m][n]; ss += x[0] * x[0] + x[1] * x[1] + x[2] * x[2] + x[3] * x[3]; }
            ss += __shfl_xor(ss, 16); ss += __shfl_xor(ss, 32);
            const float rs = rsqrtf(ss * (1.f / 64.f) + LN_EPS);
#pragma unroll
            for (int m = 0; m < 4; ++m) acc[ai][bj][m][n] = acc[ai][bj][m][n] * rs * gn[m];
          }
      }
      if (st) {
#pragma unroll
        for (int bj = 0; bj < 2; ++bj)
#pragma unroll
          for (int n = 0; n < 2; ++n) {
            const int token = t0 + 128 * bj + 32 * wc + 16 * n + fr;
            float* o = st + ((size_t)((token >> 8) * 4 + l) * 256 + (token & 255)) * 128 + kvh * 64 + 8 * fq;
#pragma unroll
            for (int m = 0; m < 4; ++m) *(f32x4_t*)(o + 32 * (m >> 1) + 4 * (m & 1)) = acc[ai][bj][m][n];
          }
      }
      if (rp) {
#pragma unroll
        for (int bj = 0; bj < 2; ++bj) {
          f32x4_t c4[2][2], s4[2][2];
#pragma unroll
          for (int n = 0; n < 2; ++n) {
            const int token = t0 + 128 * bj + 32 * wc + 16 * n + fr;
            const int nn = (token - NCTX) & 2047;
            const int pos = fq < 2 ? (nn >> 6) : (nn & 63);
#pragma unroll
            for (int m = 0; m < 2; ++m) {
              const int fo = pos * 16 + 8 * (fq & 1) + 4 * m;
              c4[n][m] = *(const f32x4_t*)(rope + fo); s4[n][m] = *(const f32x4_t*)(rope + 1024 + fo);
            }
          }
#pragma unroll
          for (int n = 0; n < 2; ++n)
#pragma unroll
            for (int m = 0; m < 2; ++m) {
              const f32x4_t x1 = acc[ai][bj][m][n], x2 = acc[ai][bj][m + 2][n];
              acc[ai][bj][m][n] = x1 * c4[n][m] - x2 * s4[n][m]; acc[ai][bj][m + 2][n] = x2 * c4[n][m] + x1 * s4[n][m];
            }
        }
      }
#pragma unroll
      for (int bj = 0; bj < 2; ++bj)
#pragma unroll
        for (int n = 0; n < 2; ++n) {
          const int token = t0 + 128 * bj + 32 * wc + 16 * n + fr;
          u16* dp = P + (size_t)token * LDP + fb + 8 * fq;
#pragma unroll
          for (int mp = 0; mp < 2; ++mp) {
            f32x4_t y0 = acc[ai][bj][2 * mp][n] * scl, y1 = acc[ai][bj][2 * mp + 1][n] * scl;
            if (act) { y0[0] = silu_f(y0[0]); y0[1] = silu_f(y0[1]); y0[2] = silu_f(y0[2]); y0[3] = silu_f(y0[3]); y1[0] = silu_f(y1[0]); y1[1] = silu_f(y1[1]); y1[2] = silu_f(y1[2]); y1[3] = silu_f(y1[3]); }
            *(uint4*)(dp + 32 * mp) = make_uint4(cvtpk(y0[0], y0[1]), cvtpk(y0[2], y0[3]), cvtpk(y1[0], y1[1]), cvtpk(y1[2], y1[3]));
          }
        }
    }
  }
};

struct EpiGate {
  __device__ __forceinline__ bool keep_acc(const Unit&) const { return false; }
  const float* b_gate; u16* G; int l;
  __device__ __forceinline__ void operator()(f32x4_t (&acc)[2][2][4][2], const Unit& u, int wid, int wr, int wc, int fr, int fq, int lane) const {
    const int f0 = u.pm * 256;
    if (f0 >= 4096) {
      const int ug = (u.pm - 16) * 48 + u.pn;
      uint4* dst = (uint4*)G + ((size_t)(ug * 8 + wid) * 16) * 64 + lane;
#pragma unroll
      for (int ai = 0; ai < 2; ++ai)
#pragma unroll
        for (int m = 0; m < 4; ++m) {
          const f32x4_t bv = *(const f32x4_t*)(b_gate + l * 3072 + (f0 - 4096) + 128 * ai + 64 * wr + 32 * (m >> 1) + 8 * fq + 4 * (m & 1));
#pragma unroll
          for (int bj = 0; bj < 2; ++bj)
#pragma unroll
            for (int n = 0; n < 2; ++n) {
              f32x4_t x = acc[ai][bj][m][n] + bv;
              x[0] = sigmoid_f(x[0]); x[1] = sigmoid_f(x[1]); x[2] = sigmoid_f(x[2]); x[3] = sigmoid_f(x[3]);
              acc[ai][bj][m][n] = x;
            }
        }
#pragma unroll
      for (int ai = 0; ai < 2; ++ai)
#pragma unroll
        for (int m = 0; m < 4; ++m)
#pragma unroll
          for (int bj = 0; bj < 2; ++bj) {
            const f32x4_t x0 = acc[ai][bj][m][0], x1 = acc[ai][bj][m][1];
            dst[((ai * 2 + bj) * 4 + m) * 64] = make_uint4(cvtpk(x0[0], x0[1]), cvtpk(x0[2], x0[3]), cvtpk(x1[0], x1[1]), cvtpk(x1[2], x1[3]));
          }
    }
  }
};

struct SchedGate {
  const char* A; const char* B; int item;
  __device__ __forceinline__ bool next(int i, Unit& u) const {
    if (i >= 2) return false;
    const int g = item * 2 + i; u.pm = 16 + g / 48; u.pn = g % 48; u.aux = 0;
    u.a = A + (size_t)u.pm * 256 * 1024 * 2; u.b = B + (size_t)u.pn * 256 * 1024 * 2; return true;
  }
};

struct SchedP4 {
  const char* A; const char* B; int c;
  __device__ __forceinline__ bool next(int i, Unit& u) const {
    if (c >= 192 || i >= 3) return false;
    tile_of(c, 4, 48, u.pm, u.pn); u.aux = i;
    u.a = A + ((size_t)i * 1024 + (size_t)u.pm * 256) * 512 * 2;
    u.b = B + ((size_t)u.pn * 256 * LDP + (i == 0 ? 0 : (i == 1 ? 1280 : 2560))) * 2; return true;
  }
};
struct EpiP4 {
  const u16* G; u16* Z;
  __device__ __forceinline__ bool keep_acc(const Unit& u) const { return u.aux < 2; }
  __device__ __forceinline__ void operator()(f32x4_t (&acc)[2][2][4][2], const Unit& u, int wid, int wr, int wc, int fr, int fq, int lane) const {
    const int br = u.aux;
    const uint4* gs = (const uint4*)G + ((size_t)(((br * 4 + u.pm) * 48 + u.pn) * 8 + wid) * 16) * 64 + lane;
    const uint4* gn = gs + (size_t)4 * 48 * 8 * 16 * 64;
#pragma unroll
    for (int ai = 0; ai < 2; ++ai)
#pragma unroll
    for (int bj = 0; bj < 2; ++bj) {
      uint4 gc[4], gx[4];
#pragma unroll
      for (int m = 0; m < 4; ++m) gc[m] = gs[((ai * 2 + bj) * 4 + m) * 64];
      if (br < 2) {
#pragma unroll
        for (int m = 0; m < 4; ++m) gx[m] = gn[((ai * 2 + bj) * 4 + m) * 64];
      }
#pragma unroll
      for (int m = 0; m < 4; ++m) {
          const uint4 g = gc[m];
          f32x4_t c0, c1;
          c0[0] = bflo(g.x); c0[1] = bfhi(g.x); c0[2] = bflo(g.y); c0[3] = bfhi(g.y);
          c1[0] = bflo(g.z); c1[1] = bfhi(g.z); c1[2] = bflo(g.w); c1[3] = bfhi(g.w);
          if (br > 0) {
#pragma unroll
            for (int j = 0; j < 4; ++j) { c0[j] = fmaxf(c0[j], 1e-30f); c1[j] = fmaxf(c1[j], 1e-30f); }
          }
          if (br < 2) {
            const uint4 h = gx[m];
            c0[0] *= __builtin_amdgcn_rcpf(fmaxf(bflo(h.x), 1e-30f)); c0[1] *= __builtin_amdgcn_rcpf(fmaxf(bfhi(h.x), 1e-30f)); c0[2] *= __builtin_amdgcn_rcpf(fmaxf(bflo(h.y), 1e-30f)); c0[3] *= __builtin_amdgcn_rcpf(fmaxf(bfhi(h.y), 1e-30f));
            c1[0] *= __builtin_amdgcn_rcpf(fmaxf(bflo(h.z), 1e-30f)); c1[1] *= __builtin_amdgcn_rcpf(fmaxf(bfhi(h.z), 1e-30f)); c1[2] *= __builtin_amdgcn_rcpf(fmaxf(bflo(h.w), 1e-30f)); c1[3] *= __builtin_amdgcn_rcpf(fmaxf(bfhi(h.w), 1e-30f));
            acc[ai][bj][m][0] *= c0; acc[ai][bj][m][1] *= c1;
          } else {
            acc[ai][bj][m][0] *= c0; acc[ai][bj][m][1] *= c1;
          }
      }
      if (br == 2) {
        const int tk = u.pn * 256 + 128 * bj + 32 * wc + fr;
        u16* zp = Z + (size_t)tk * 1024 + u.pm * 256 + 128 * ai + 64 * wr + 8 * fq;
#pragma unroll
        for (int mp = 0; mp < 2; ++mp) {
          const f32x4_t a0 = acc[ai][bj][2 * mp][0], a1 = acc[ai][bj][2 * mp + 1][0], b0 = acc[ai][bj][2 * mp][1], b1 = acc[ai][bj][2 * mp + 1][1];
          *(uint4*)(zp + 32 * mp) = make_uint4(cvtpk(a0[0], a0[1]), cvtpk(a0[2], a0[3]), cvtpk(a1[0], a1[1]), cvtpk(a1[2], a1[3]));
          *(uint4*)(zp + 16 * 1024 + 32 * mp) = make_uint4(cvtpk(b0[0], b0[1]), cvtpk(b0[2], b0[3]), cvtpk(b1[0], b1[1]), cvtpk(b1[2], b1[3]));
        }
      }
    }
  }
};

struct SchedP5 {
  const char* A; const char* B; int c;
  __device__ __forceinline__ bool next(int i, Unit& u) const {
    if (c >= 192 || i >= 1) return false;
    tile_of(c, 4, 48, u.pm, u.pn); u.aux = 0;
    u.a = A + (size_t)u.pm * 256 * 1024 * 2; u.b = B + (size_t)u.pn * 256 * 1024 * 2; return true;
  }
};
struct EpiP5 {
  const float* mod; const float* xp; const float* xs; float* out; int l;
  __device__ __forceinline__ bool keep_acc(const Unit&) const { return false; }
  __device__ __forceinline__ void operator()(f32x4_t (&acc)[2][2][4][2], const Unit& u, int wid, int wr, int wc, int fr, int fq, int lane) const {
    const int t0 = u.pn * 256;
    const int mv = t0 < NCTX ? 2 : ((t0 - NCTX) >> 11);
    const float* gt = mod + (l * 3 + mv) * 3072 + 2048 + u.pm * 256 + 64 * wr + 8 * fq;
    f32x4_t gv[2][4];
#pragma unroll
    for (int ai = 0; ai < 2; ++ai)
#pragma unroll
      for (int m = 0; m < 4; ++m) gv[ai][m] = *(const f32x4_t*)(gt + 128 * ai + 32 * (m >> 1) + 4 * (m & 1));
#pragma unroll
    for (int bj = 0; bj < 2; ++bj)
#pragma unroll
      for (int n = 0; n < 2; ++n) {
        const int token = t0 + 128 * bj + 32 * wc + 16 * n + fr;
        const float* xsrc = ((l == 0) ? (token < NCTX ? xp + (size_t)token * 1024 : xs + (size_t)(token - NCTX) * 1024) : out + (size_t)token * 1024) + u.pm * 256 + 64 * wr + 8 * fq;
        float* od = out + (size_t)token * 1024 + u.pm * 256 + 64 * wr + 8 * fq;
        f32x4_t xv[2][4];
#pragma unroll
        for (int ai = 0; ai < 2; ++ai)
#pragma unroll
          for (int m = 0; m < 4; ++m) xv[ai][m] = *(const f32x4_t*)(xsrc + 128 * ai + 32 * (m >> 1) + 4 * (m & 1));
#pragma unroll
        for (int ai = 0; ai < 2; ++ai)
#pragma unroll
          for (int m = 0; m < 4; ++m) *(f32x4_t*)(od + 128 * ai + 32 * (m >> 1) + 4 * (m & 1)) = ALPHA * xv[ai][m] + gv[ai][m] * acc[ai][bj][m][n];
      }
  }
};

__device__ __forceinline__ void attn_item(u16* Qp, const u16* Gp,
                          const u16* K0, const u16* V0, int ld0, int n0, bool masked, int kpos0, int qpos0,
                          const u16* K1, const u16* V1, int ld1, int n1, bool has_sink, float sink, char* lds, int tid_in) {
  int tid = tid_in; asm volatile("" : "+v"(tid));
  const int lane = tid & 63, wid = tid >> 6, r32 = lane & 31, hi = lane >> 5;
  bf16x8 qr[4];
#pragma unroll
  for (int d0 = 0; d0 < 4; ++d0) qr[d0] = *(const bf16x8*)(Qp + (size_t)(wid * 32 + r32) * LDP + d0 * 16 + hi * 8);
  const int np0 = n0 >> 7, NI = np0 + (n1 >> 7);
  uint4 kr0, kr1, vr0, vr1;
#define ATT_GLOAD(i_) do { const int i__ = (i_); const u16 *kp, *vp; int ld; \
    if (i__ < np0) { kp = K0 + (size_t)i__ * 128 * ld0; vp = V0 + (size_t)i__ * 128 * ld0; ld = ld0; } \
    else { kp = K1 + (size_t)(i__ - np0) * 128 * ld1; vp = V1 + (size_t)(i__ - np0) * 128 * ld1; ld = ld1; } \
    kr0 = *(const uint4*)(kp + (size_t)(tid >> 3) * ld + (tid & 7) * 8); \
    kr1 = *(const uint4*)(kp + (size_t)(64 + (tid >> 3)) * ld + (tid & 7) * 8); \
    vr0 = *(const uint4*)(vp + (size_t)((tid & 255) >> 2) * ld + (tid >> 8) * 32 + (tid & 3) * 8); \
    vr1 = *(const uint4*)(vp + (size_t)(64 + ((tid & 255) >> 2)) * ld + (tid >> 8) * 32 + (tid & 3) * 8); } while (0)
#define ATT_LWRITE(buf_) do { const int b__ = (buf_); \
    *(uint4*)(lds + b__ * 18432 + (tid >> 3) * 144 + (tid & 7) * 16) = kr0; \
    *(uint4*)(lds + b__ * 18432 + 9216 + (tid >> 3) * 144 + (tid & 7) * 16) = kr1; \
    *(uint4*)(lds + 36864 + b__ * 16384 + tid * 16) = vr0; \
    *(uint4*)(lds + 36864 + b__ * 16384 + 8192 + tid * 16) = vr1; } while (0)
  f32x16 o[2];
#pragma unroll
  for (int r = 0; r < 16; ++r) { o[0][r] = 0.f; o[1][r] = 0.f; }
  float m = -1e30f, lsum = 0.f;
  const int qpos = qpos0 + wid * 32 + r32;
  const int vlane = ((lane >> 4) & 1) * 32 + (lane & 3) * 8 + (4 * hi + ((lane & 15) >> 2)) * 64;
#define ATT_MASK(sa, sb, tt_) do { const int kb0 = kpos0 + (tt_) * 64 + 4 * hi; \
      _Pragma("unroll") for (int r = 0; r < 16; ++r) { \
        const int kp = kb0 + (r & 3) + 8 * (r >> 2); \
        int e0 = qpos - kp; e0 = e0 < 0 ? -e0 : e0; \
        int e1 = qpos - kp - 32; e1 = e1 < 0 ? -e1 : e1; \
        if (e0 > 128) sa[r] = -1e30f; \
        if (e1 > 128) sb[r] = -1e30f; } } while (0)
#define ATT_PACK(sx, h_) __builtin_bit_cast(bf16x8, make_uint4(cvtpk(sx[8 * (h_) + 0], sx[8 * (h_) + 1]), cvtpk(sx[8 * (h_) + 2], sx[8 * (h_) + 3]), cvtpk(sx[8 * (h_) + 4], sx[8 * (h_) + 5]), cvtpk(sx[8 * (h_) + 6], sx[8 * (h_) + 7])))
#define ATT_PV1(vb_, off_, pf_) do { \
    _Pragma("unroll") for (int db = 0; db < 2; ++db) { \
      const lds_cptr vp_ = (vb_) + db * 4096 + (off_) * 64; \
      const s16x4 lo_ = vtr(vp_), hh_ = vtr(vp_ + 512); \
      const bf16x8 vf_ = (bf16x8){lo_[0], lo_[1], lo_[2], lo_[3], hh_[0], hh_[1], hh_[2], hh_[3]}; \
      o[db] = MFMA(vf_, pf_, o[db]); } } while (0)
  ATT_GLOAD(0); ATT_LWRITE(0);
  __syncthreads();
  for (int i = 0; i < NI; ++i) {
    const int buf = i & 1;
    if (i + 1 < NI) ATT_GLOAD(i + 1);
    const char* kb_ = lds + buf * 18432 + r32 * 144 + hi * 16;
    f32x16 s0, s1, s2, s3;
#pragma unroll
    for (int r = 0; r < 16; ++r) { s0[r] = 0.f; s1[r] = 0.f; s2[r] = 0.f; s3[r] = 0.f; }
#pragma unroll
    for (int d0 = 0; d0 < 4; ++d0) {
      const bf16x8 k0 = *(const bf16x8*)(kb_ + d0 * 32), k1 = *(const bf16x8*)(kb_ + 32 * 144 + d0 * 32);
      const bf16x8 k2 = *(const bf16x8*)(kb_ + 9216 + d0 * 32), k3 = *(const bf16x8*)(kb_ + 9216 + 32 * 144 + d0 * 32);
      s0 = MFMA(k0, qr[d0], s0); s1 = MFMA(k1, qr[d0], s1); s2 = MFMA(k2, qr[d0], s2); s3 = MFMA(k3, qr[d0], s3);
    }
    if (masked && i < np0) { ATT_MASK(s0, s1, 2 * i); ATT_MASK(s2, s3, 2 * i + 1); }
    float mx = fmaxf(fmaxf(s0[0], s1[0]), fmaxf(s2[0], s3[0]));
#pragma unroll
    for (int r = 1; r < 16; ++r) mx = fmaxf(mx, fmaxf(fmaxf(s0[r], s1[r]), fmaxf(s2[r], s3[r])));
    mx = fmaxf(mx, __shfl_xor(mx, 32));
    if (__any(mx > m)) {
      const float mn = fmaxf(m, mx); const float alpha = __builtin_amdgcn_exp2f(m - mn); m = mn; lsum *= alpha;
#pragma unroll
      for (int r = 0; r < 16; ++r) { o[0][r] *= alpha; o[1][r] *= alpha; }
    }
    float ps = 0.f;
#pragma unroll
    for (int r = 0; r < 16; ++r) {
      s0[r] = __builtin_amdgcn_exp2f(s0[r] - m); s1[r] = __builtin_amdgcn_exp2f(s1[r] - m); s2[r] = __builtin_amdgcn_exp2f(s2[r] - m); s3[r] = __builtin_amdgcn_exp2f(s3[r] - m);
      ps += (s0[r] + s1[r]) + (s2[r] + s3[r]);
    }
    lsum += ps;
    const lds_cptr vb0 = (lds_cptr)(lds + 36864 + buf * 16384) + vlane;
    const lds_cptr vb1 = vb0 + 8192;
    { const bf16x8 pa = ATT_PACK(s0, 0), pb = ATT_PACK(s1, 0), pc = ATT_PACK(s0, 1), pd = ATT_PACK(s1, 1);
      ATT_PV1(vb0, 0, pa); ATT_PV1(vb0, 32, pb); ATT_PV1(vb0, 16, pc); ATT_PV1(vb0, 48, pd); }
    { const bf16x8 pa = ATT_PACK(s2, 0), pb = ATT_PACK(s3, 0), pc = ATT_PACK(s2, 1), pd = ATT_PACK(s3, 1);
      ATT_PV1(vb1, 0, pa); ATT_PV1(vb1, 32, pb); ATT_PV1(vb1, 16, pc); ATT_PV1(vb1, 48, pd); }
    if (i + 1 < NI) ATT_LWRITE(buf ^ 1);
    __syncthreads();
  }
#undef ATT_GLOAD
#undef ATT_LWRITE
#undef ATT_MASK
#undef ATT_PACK
#undef ATT_PV1
  float lt = lsum + __shfl_xor(lsum, 32);
  float inv;
  if (has_sink) { const float sk = sink * 1.4426950408889634f; const float mf = fmaxf(m, sk); const float sc = __builtin_amdgcn_exp2f(m - mf); inv = sc / (lt * sc + __builtin_amdgcn_exp2f(sk - mf)); }
  else inv = 1.f / lt;
  u16* Op = Qp + (size_t)(wid * 32 + r32) * LDP;
  const u16* Gq = Gp + (size_t)(wid * 32 + r32) * LDP;
  uint2 gg[2][4];
#pragma unroll
  for (int db = 0; db < 2; ++db)
#pragma unroll
    for (int rq = 0; rq < 4; ++rq) gg[db][rq] = *(const uint2*)(Gq + db * 32 + 8 * rq + 4 * hi);
#pragma unroll
  for (int db = 0; db < 2; ++db)
#pragma unroll
    for (int rq = 0; rq < 4; ++rq) {
      const int d = db * 32 + 8 * rq + 4 * hi;
      const uint2 g = gg[db][rq];
      const float v0 = o[db][rq * 4 + 0] * inv * bflo(g.x), v1 = o[db][rq * 4 + 1] * inv * bfhi(g.x);
      const float v2 = o[db][rq * 4 + 2] * inv * bflo(g.y), v3 = o[db][rq * 4 + 3] * inv * bfhi(g.y);
      *(uint2*)(Op + d) = make_uint2(cvtpk(v0, v1), cvtpk(v2, v3));
    }
}

__device__ __forceinline__ void sgu_chunk(const Params& p, int l, int chunk, char* lds, int tid_in) {
  int tid = tid_in; asm volatile("" : "+v"(tid));
  const int lane = tid & 63, wid = tid >> 6, r32 = lane & 31, hi = lane >> 5;
  const int wc = wid >> 2, wp = wid & 3;
  const int R0 = chunk * 128;
  u16* Pr = p.P + (size_t)R0 * LDP;
  float* stt = (float*)(lds + 67584);
#pragma unroll
  for (int half = 0; half < 2; ++half) {
    uint4 raw[8];
#pragma unroll
    for (int rr = 0; rr < 8; ++rr) raw[rr] = *(const uint4*)(Pr + (size_t)(wid * 16 + half * 8 + rr) * LDP + 3072 + lane * 8);
#pragma unroll
    for (int rr = 0; rr < 8; ++rr) {
      const int row = wid * 16 + half * 8 + rr;
      const float x0 = bflo(raw[rr].x), x1 = bfhi(raw[rr].x), x2 = bflo(raw[rr].y), x3 = bfhi(raw[rr].y), x4 = bflo(raw[rr].z), x5 = bfhi(raw[rr].z), x6 = bflo(raw[rr].w), x7 = bfhi(raw[rr].w);
      const float mean = wave_sum(((x0 + x1) + (x2 + x3)) + ((x4 + x5) + (x6 + x7))) * (1.f / 512.f);
      const float d0 = x0 - mean, d1 = x1 - mean, d2 = x2 - mean, d3 = x3 - mean, d4 = x4 - mean, d5 = x5 - mean, d6 = x6 - mean, d7 = x7 - mean;
      const float rstd = rsqrtf(wave_sum(((d0 * d0 + d1 * d1) + (d2 * d2 + d3 * d3)) + ((d4 * d4 + d5 * d5) + (d6 * d6 + d7 * d7))) * (1.f / 512.f) + LN_EPS);
      if (lane == 0) { stt[row * 2] = mean; stt[row * 2 + 1] = rstd; }
    }
  }
  __syncthreads();
  const int ch = tid & 15, row0 = tid >> 4;
  uint4 wr0, wr1, wr2, wr3, vr0, vr1, vr2, vr3; f32x4 g0, g1, b0, b1;
#define SGU_GL1(i_, w_, v_, Wg_, g_) do { w_ = *(const uint4*)((Wg_) + (row0 + 32 * (i_)) * 128 + ch * 8); \
      v_ = *(const uint4*)(Pr + (size_t)(row0 + 32 * (i_)) * LDP + 3072 + (g_) * 128 + ch * 8); } while (0)
#define SGU_GLOAD(g_) do { const u16* Wg_ = p.wsp + (size_t)(l * 4 + (g_)) * 128 * 128; \
    SGU_GL1(0, wr0, vr0, Wg_, g_); SGU_GL1(1, wr1, vr1, Wg_, g_); SGU_GL1(2, wr2, vr2, Wg_, g_); SGU_GL1(3, wr3, vr3, Wg_, g_); \
    const float* gm_ = p.sgu_g + l * 512 + (g_) * 128 + ch * 8; const float* bt_ = p.sgu_b + l * 512 + (g_) * 128 + ch * 8; \
    g0 = *(const f32x4*)gm_; g1 = *(const f32x4*)(gm_ + 4); b0 = *(const f32x4*)bt_; b1 = *(const f32x4*)(bt_ + 4); } while (0)
#define SGU_LW1(i_, w_, v_) do { const int row = row0 + 32 * (i_); \
      *(uint4*)(lds + row * 272 + ch * 16) = w_; \
      const uint4 raw = v_; const float mean = stt[row * 2], rstd = stt[row * 2 + 1]; \
      const float y0 = (bflo(raw.x) - mean) * rstd * g0[0] + b0[0], y1 = (bfhi(raw.x) - mean) * rstd * g0[1] + b0[1]; \
      const float y2 = (bflo(raw.y) - mean) * rstd * g0[2] + b0[2], y3 = (bfhi(raw.y) - mean) * rstd * g0[3] + b0[3]; \
      const float y4 = (bflo(raw.z) - mean) * rstd * g1[0] + b1[0], y5 = (bfhi(raw.z) - mean) * rstd * g1[1] + b1[1]; \
      const float y6 = (bflo(raw.w) - mean) * rstd * g1[2] + b1[2], y7 = (bfhi(raw.w) - mean) * rstd * g1[3] + b1[3]; \
      *(uint4*)(lds + 34816 + (ch >> 2) * 8192 + row * 64 + (ch & 3) * 16) = make_uint4(cvtpk(y0, y1), cvtpk(y2, y3), cvtpk(y4, y5), cvtpk(y6, y7)); } while (0)
#define SGU_LWRITE() do { SGU_LW1(0, wr0, vr0); SGU_LW1(1, wr1, vr1); SGU_LW1(2, wr2, vr2); SGU_LW1(3, wr3, vr3); } while (0)
  SGU_GLOAD(0); SGU_LWRITE();
  __syncthreads();
  const lds_cptr vnb = (lds_cptr)(lds + 34816) + ((lane >> 4) & 1) * 32 + (lane & 3) * 8 + (8 * hi + ((lane & 15) >> 2)) * 64;
  const char* wb = lds + (wp * 32 + r32) * 272 + hi * 16;
  const int prow = wp * 32 + r32;
  u16* rowp = Pr + (size_t)prow * LDP;
#pragma unroll
  for (int g = 0; g < 4; ++g) {
    const int cg0 = g * 128;
    if (g < 3) SGU_GLOAD(g + 1);
    const float bs = p.b_spatial[(l * 4 + g) * 128 + prow];
    uint2 uu[2][4], gq[2][4];
#pragma unroll
    for (int ci = 0; ci < 2; ++ci)
#pragma unroll
      for (int rq = 0; rq < 4; ++rq) { const int c = cg0 + wc * 64 + ci * 32 + 8 * rq + 4 * hi; uu[ci][rq] = *(const uint2*)(rowp + 2560 + c); gq[ci][rq] = *(const uint2*)(rowp + 3584 + c); }
    f32x16 acc[2];
#pragma unroll
    for (int r = 0; r < 16; ++r) { acc[0][r] = 0.f; acc[1][r] = 0.f; }
#pragma unroll
    for (int ks = 0; ks < 8; ++ks) {
      const bf16x8 bfr = *(const bf16x8*)(wb + ks * 32);
#pragma unroll
      for (int ci = 0; ci < 2; ++ci) {
        const lds_cptr vp = vnb + (wc * 2 + ci) * 8192 + ks * 16 * 64;
        const s16x4 lo = vtr(vp), hh = vtr(vp + 256);
        const bf16x8 af = (bf16x8){lo[0], lo[1], lo[2], lo[3], hh[0], hh[1], hh[2], hh[3]};
        acc[ci] = MFMA(af, bfr, acc[ci]);
      }
    }
#pragma unroll
    for (int ci = 0; ci < 2; ++ci)
#pragma unroll
      for (int rq = 0; rq < 4; ++rq) {
        const int c = cg0 + wc * 64 + ci * 32 + 8 * rq + 4 * hi;
        const uint2 u = uu[ci][rq], gg = gq[ci][rq];
        const float v0 = bflo(u.x) * (acc[ci][rq * 4 + 0] + bs) * bflo(gg.x), v1 = bfhi(u.x) * (acc[ci][rq * 4 + 1] + bs) * bfhi(gg.x);
        const float v2 = bflo(u.y) * (acc[ci][rq * 4 + 2] + bs) * bflo(gg.y), v3 = bfhi(u.y) * (acc[ci][rq * 4 + 3] + bs) * bfhi(gg.y);
        *(uint2*)(rowp + 2560 + c) = make_uint2(cvtpk(v0, v1), cvtpk(v2, v3));
      }
    if (g < 3) {
      __syncthreads();
      SGU_LWRITE();
      __syncthreads();
    }
  }
#undef SGU_GL1
#undef SGU_GLOAD
#undef SGU_LW1
#undef SGU_LWRITE
}

__device__ __forceinline__ void phase_p3(const Params& p, int l, char* lds, int wv) {
  const int tid = opaque_tid(wv);
  volatile int* slot = (volatile int*)(lds + LDS_ITEM);
  while (true) {
    __syncthreads();
    if (tid == 0) *slot = atomicAdd(&p.cnt[l], 1);
    __syncthreads();
    const int item0 = *slot;
    if (item0 >= 288 + 864) break;
    if (item0 >= 128 && item0 < 416) {
      SchedGate S{(const char*)p.wt_ig, (const char*)p.H, item0 - 128};
      EpiGate E{p.b_gate, p.G, l};
      int tid2 = tid; asm volatile("" : "+v"(tid2));
      gemm_phase((LAS unsigned char*)lds, 1024, 1024, 1024, S, E, tid2);
      continue;
    }
    const int item = item0 < 128 ? item0 : item0 - 288;
    if (item >= 256 && item < 352) {
      sgu_chunk(p, l, item - 256, lds, tid);
    } else {
      u16* Qp; const u16 *Gp, *K0, *V0, *K1, *V1; int n0, n1, kpos0 = 0, qpos0 = 0; bool masked = false, has_sink = false; float sink = 0.f;
      if (item < 256) {
        const bool isB = item >= 128; const int it = item & 127;
        const int b = it >> 6, head = (it >> 3) & 7, qb = it & 7, kv = head >> 2;
        u16* base = p.P + (size_t)(NCTX + b * 2048) * LDP;
        const size_t coff = ((size_t)(b * 4 + l) * 512) * 128 + kv * 64;
        n1 = 512;
        if (!isB) {
          Qp = base + (size_t)qb * 256 * LDP + head * 64; Gp = base + (size_t)qb * 256 * LDP + 768 + head * 64;
          K0 = base + 512 + kv * 64; V0 = base + 640 + kv * 64; n0 = 2048;
          K1 = p.cachebf + coff; V1 = p.cachebf + 524288 + coff;
        } else {
          const int ks = qb * 256 - 128 < 0 ? 0 : qb * 256 - 128;
          const int ke = qb * 256 + 384 > 2048 ? 2048 : qb * 256 + 384;
          Qp = base + (size_t)qb * 256 * LDP + 1280 + head * 64; Gp = base + (size_t)qb * 256 * LDP + 2048 + head * 64;
          K0 = base + (size_t)ks * LDP + 1792 + kv * 64; V0 = base + (size_t)ks * LDP + 1920 + kv * 64; n0 = ke - ks;
          masked = true; kpos0 = ks; qpos0 = qb * 256;
          K1 = p.cachebf + 2 * 524288 + coff; V1 = p.cachebf + 3 * 524288 + coff;
          has_sink = true; sink = p.sink[l * 8 + head];
        }
      } else {
        const int it0 = item - 352; const bool isB = it0 >= 256; const int it = it0 & 255;
        const int b = it >> 3, head = it & 7, kv = head >> 2;
        u16* base = p.P + (size_t)(b * 256) * LDP;
        n0 = 256; n1 = 0; K1 = base; V1 = base;
        if (!isB) {
          Qp = base + head * 64; Gp = base + 768 + head * 64;
          K0 = base + 512 + kv * 64; V0 = base + 640 + kv * 64;
        } else {
          Qp = base + 1280 + head * 64; Gp = base + 2048 + head * 64;
          K0 = base + 1792 + kv * 64; V0 = base + 1920 + kv * 64;
          has_sink = true; sink = p.sink[l * 8 + head];
        }
      }
      attn_item(Qp, Gp, K0, V0, LDP, n0, masked, kpos0, qpos0, K1, V1, n1 ? 128 : LDP, n1, has_sink, sink, lds, tid);
    }
  }
  __syncthreads();
}

__device__ __forceinline__ void phase_p2(const Params& p, int l, char* lds, int wv) {
  const int tid = opaque_tid(wv);
  SchedP2 S{(const char*)p.wt_ig, (const char*)p.H, (int)gridDim.x, block_id()};
  EpiP2 E{p.b_gate, p.q_norm, p.k_norm, p.rope, p.out + (size_t)NTOK * 1024, p.P, p.G, l};
  gemm_phase((LAS unsigned char*)lds, 1024, 1024, 1024, S, E, tid);
  __syncthreads();
}
__device__ __forceinline__ void phase_p4(const Params& p, int l, char* lds, int wv) {
  const int tid = opaque_tid(wv);
  SchedP4 S{(const char*)p.wt_p, (const char*)p.P, block_id()};
  EpiP4 E{p.G, p.H};
  gemm_phase((LAS unsigned char*)lds, 512, 512, LDP, S, E, tid);
  __syncthreads();
}
__device__ __forceinline__ void phase_p5(const Params& p, int l, char* lds, int wv) {
  const int tid = opaque_tid(wv);
  SchedP5 S{(const char*)p.wt_o, (const char*)p.H, block_id()};
  EpiP5 E{p.mod, p.x_prompt, p.x_sample, p.out, l};
  gemm_phase((LAS unsigned char*)lds, 1024, 1024, 1024, S, E, tid);
  __syncthreads();
}

__device__ __forceinline__ Params load_params() {
#if defined(__HIP_DEVICE_COMPILE__)
  const __attribute__((address_space(4))) char* kp = (const __attribute__((address_space(4))) char*)__builtin_amdgcn_kernarg_segment_ptr();
  asm volatile("" : "+s"(kp));
  return *(const __attribute__((address_space(4))) Params*)kp;
#else
  return Params{};
#endif
}
__device__ __forceinline__ void run_phase(int ph, char* lds, int wv) {
  const Params p = load_params();
  if (ph == 0) { phase_pre(p, lds, wv); return; }
  const int k = ph + 3, l = k / 5 - 1, s = k - (l + 1) * 5;
  if (s == 0) phase_p2(p, l, lds, wv);
  else if (s == 1) phase_p3(p, l, lds, wv);
  else if (s == 2) phase_p4(p, l, lds, wv);
  else if (s == 3) phase_p5(p, l, lds, wv);
  else phase_row(p, l + 1, lds, wv);
}

__global__ void __launch_bounds__(512, 2) fwd_megakernel(Params p, int ph0, int ph1) {
  __shared__ __attribute__((aligned(16))) char lds[LDS_BYTES];
  if (ph1 < 0) cg::this_grid().sync();
  int wv;
  wv = __builtin_amdgcn_readfirstlane((int)(threadIdx.x >> 6));
  run_phase(0, lds, wv);
  hier_barrier(load_params().bar, 0u, wv);
  for (int ph = 1; ph < ph1; ++ph) {
    run_phase(ph, lds, wv);
    if (ph + 1 < ph1) hier_barrier(load_params().bar, (unsigned)ph, wv);
  }
}

extern "C" void kernel_launch(void* const* d_in, const int* in_sizes, int n_in, void* d_out, int out_size, void* d_ws, size_t ws_size, hipStream_t stream) {
  static int grid_blocks = 0;
  if (!grid_blocks) {
    int dev = 0, cus = 0, per_cu = 0;
    (void)hipGetDevice(&dev);
    (void)hipDeviceGetAttribute(&cus, hipDeviceAttributeMultiprocessorCount, dev);
    (void)hipOccupancyMaxActiveBlocksPerMultiprocessor(&per_cu, fwd_megakernel, NTHR, 0);
    if (per_cu < 1) fprintf(stderr, "occupancy query returned %d\n", per_cu);
    grid_blocks = cus;
  }
  Params p{};
  p.x_prompt = (const float*)d_in[0]; p.x_sample = (const float*)d_in[1];
  p.cache0 = (const float*)d_in[2]; p.cache1 = (const float*)d_in[3]; p.cache2 = (const float*)d_in[4]; p.cache3 = (const float*)d_in[5];
  p.c = (const float*)d_in[6]; p.c_ctx = (const float*)d_in[7];
  p.w_mod = (const float*)d_in[8]; p.b_mod = (const float*)d_in[9]; p.w_in = (const float*)d_in[10];
  p.q_norm = (const float*)d_in[11]; p.k_norm = (const float*)d_in[12]; p.sink = (const float*)d_in[13];
  p.sgu_g = (const float*)d_in[14]; p.sgu_b = (const float*)d_in[15]; p.w_spatial = (const float*)d_in[16]; p.b_spatial = (const float*)d_in[17];
  p.w_proj0 = (const float*)d_in[18]; p.w_proj1 = (const float*)d_in[19]; p.w_proj2 = (const float*)d_in[20];
  p.w_gate = (const float*)d_in[21]; p.b_gate = (const float*)d_in[22]; p.w_out = (const float*)d_in[23];
  p.ln_g = (const float*)d_in[24]; p.ln_b = (const float*)d_in[25];
  p.out = (float*)d_out;
  char* w = (char*)d_ws; size_t off = 0;
  auto take = [&](size_t bytes) { char* r = w + off; off += (bytes + 255) & ~(size_t)255; return r; };
  p.mod = (float*)take(4 * 3 * 3072 * 4);
  p.rope = (float*)take(2048 * 4);
  p.bar = (unsigned*)take(XCD_BAR_WORDS * 4);
  p.cnt = (int*)take(1024);
  p.wsp = (u16*)take(262144 * 2);
  p.cachebf = (u16*)take((size_t)4 * 524288 * 2);
  p.wt_ig = (u16*)take((size_t)7168 * 1024 * 2);
  p.wt_p = (u16*)take((size_t)3 * 1024 * 512 * 2);
  p.wt_o = (u16*)take((size_t)1024 * 1024 * 2);
  p.H = (u16*)take((size_t)NTOK * 1024 * 2);
  p.P = (u16*)take((size_t)NTOK * LDP * 2);
  p.G = (u16*)take((size_t)NTOK * 3072 * 2);
  if (off > ws_size) { fprintf(stderr, "workspace too small: need %zu have %zu\n", off, ws_size); return; }
  (void)hipMemsetAsync(p.bar, 0, XCD_BAR_WORDS * 4 + 1024, stream);
  int ph0 = 0, ph1 = 22;
  void* args[] = {&p, &ph0, &ph1};
  hipError_t e = hipLaunchCooperativeKernel((void*)fwd_megakernel, dim3(grid_blocks), dim3(NTHR), args, 0, stream);
  if (e != hipSuccess) fprintf(stderr, "cooperative launch failed: %s (grid %d)\n", hipGetErrorString(e), grid_blocks);
}
```

```cpp
#include <hip/hip_runtime.h>
#include <hip/hip_cooperative_groups.h>
#include <cstdio>
#include <cstdint>
namespace cg = cooperative_groups;

#ifndef COOP
#define COOP 1
#endif

typedef unsigned short u16;
using bf16x8 = __attribute__((ext_vector_type(8))) short;
using s16x4 = __attribute__((ext_vector_type(4))) short;
using f32x16 = __attribute__((ext_vector_type(16))) float;
using f32x4 = __attribute__((ext_vector_type(4))) float;
typedef float f32x4_t __attribute__((ext_vector_type(4)));
typedef short v4i16_t __attribute__((ext_vector_type(4)));
typedef __attribute__((address_space(3))) const char* lds_cptr;

#define MFMA(a, b, c) __builtin_amdgcn_mfma_f32_32x32x16_bf16(a, b, c, 0, 0, 0)

constexpr int NTOK = 12288, NCTX = 8192;
constexpr int NTHR = 512, NWAVE = 8;
constexpr int LDP = 4096 + 128;
constexpr int LDS_BYTES = 131072 + 64;
constexpr int LDS_ITEM = 131072;
constexpr float ALPHA = 1.681792830507429f;
constexpr float LN_EPS = 1e-6f;

struct Params {
  const float* x_prompt; const float* x_sample; const float* cache0; const float* cache1; const float* cache2; const float* cache3; const float* c; const float* c_ctx;
  const float* w_mod; const float* b_mod; const float* w_in; const float* q_norm; const float* k_norm; const float* sink;
  const float* sgu_g; const float* sgu_b; const float* w_spatial; const float* b_spatial;
  const float* w_proj0; const float* w_proj1; const float* w_proj2; const float* w_gate; const float* b_gate; const float* w_out; const float* ln_g; const float* ln_b;
  float* out;
  float* mod; float* rope; unsigned* bar; int* cnt; u16* wsp; u16* cachebf; u16* wt_ig; u16* wt_p; u16* wt_o; u16* H; u16* P; u16* G;
};

__device__ __forceinline__ unsigned cvtpk(float lo, float hi) { unsigned r; asm("v_cvt_pk_bf16_f32 %0, %1, %2" : "=v"(r) : "v"(lo), "v"(hi)); return r; }
__device__ __forceinline__ float bflo(unsigned u) { return __uint_as_float(u << 16); }
__device__ __forceinline__ float bfhi(unsigned u) { return __uint_as_float(u & 0xffff0000u); }
__device__ __forceinline__ int crow(int r, int hi) { return (r & 3) + 8 * (r >> 2) + 4 * hi; }
__device__ __forceinline__ float silu_f(float x) { return x * __builtin_amdgcn_rcpf(1.f + __builtin_amdgcn_exp2f(-1.4426950408889634f * x)); }
__device__ __forceinline__ float sigmoid_f(float x) { return __builtin_amdgcn_rcpf(1.f + __builtin_amdgcn_exp2f(-1.4426950408889634f * x)); }
__device__ __forceinline__ s16x4 vtr(lds_cptr p) { return __builtin_bit_cast(s16x4, __builtin_amdgcn_ds_read_tr16_b64_v4i16((__attribute__((address_space(3))) v4i16_t*)p)); }
__device__ __forceinline__ int block_id() { int b = (int)blockIdx.x; asm volatile("" : "+s"(b)); return b; }
__device__ __forceinline__ int lane_id() { unsigned z = 0u; asm volatile("" : "+s"(z)); return (int)__builtin_amdgcn_mbcnt_hi(~0u, __builtin_amdgcn_mbcnt_lo(~0u, z)); }
__device__ __forceinline__ int opaque_tid(int wv) { asm volatile("" : "+s"(wv)); int t = wv * 64 + lane_id(); asm volatile("" : "+v"(t)); return t; }
__device__ __forceinline__ float wave_sum(float v) {
#pragma unroll
  for (int o = 32; o > 0; o >>= 1) v += __shfl_xor(v, o);
  return v;
}


#define XB_TMO      128
#define XB_XCNT(j)  (256  + 64 * (j))
#define XB_XSUB(j)  (1280 + 64 * (j))
#define XB_XGEN(j)  (2304 + 64 * (j))
#define XB_TOP      3328
#define XB_TOPGEN   3392
#define XCD_BAR_WORDS 3456
#define XB_SPIN_CAP (1u << 18)
#define LAS __attribute__((address_space(3)))
__device__ __forceinline__ unsigned xb_ld(unsigned* p)              { return __hip_atomic_load(p, __ATOMIC_RELAXED, __HIP_MEMORY_SCOPE_AGENT); }
__device__ __forceinline__ unsigned xb_add(unsigned* p, unsigned v) { return __hip_atomic_fetch_add(p, v, __ATOMIC_RELAXED, __HIP_MEMORY_SCOPE_AGENT); }
__device__ __forceinline__ unsigned xb_xcc_id() { return (unsigned)__builtin_amdgcn_s_getreg((3 << 11) | 20) & 0xFu; }
#define XB_SPIN(cond, bar) do { unsigned _sp = 0; while (cond) { __builtin_amdgcn_s_sleep(1); \
    if ((++_sp & 255u) == 0u) { if (xb_ld(&(bar)[XB_TMO])) break; if (_sp > XB_SPIN_CAP) { atomicAdd(&(bar)[XB_TMO], 1u); break; } } } } while (0)
struct XcdBarrier { unsigned* bar; unsigned x; volatile LAS unsigned* st; };
__device__ __forceinline__ XcdBarrier xcd_barrier_post(unsigned* bar, volatile LAS unsigned* st) {
    XcdBarrier b; b.bar = bar; b.x = xb_xcc_id(); b.st = st;
    if (threadIdx.x == 0) (void)xb_add(&bar[XB_XCNT(b.x)], 1u);
    return b;
}
__device__ __forceinline__ void xcd_barrier_complete(unsigned* bar, unsigned x, unsigned& nloc, unsigned& nx) {
    const unsigned G = gridDim.x * gridDim.y * gridDim.z;
    unsigned sum, cnt, mine, sp = 0u;
    for (;;) {
        sum = 0u; cnt = 0u; mine = 0u;
#pragma unroll
        for (unsigned j = 0; j < 16; ++j) { const unsigned c = xb_ld(&bar[XB_XCNT(j)]); sum += c; cnt += (c > 0u) ? 1u : 0u; mine = (j == x) ? c : mine; }
        if (sum == G) break;
        __builtin_amdgcn_s_sleep(1);
        if ((++sp & 255u) == 0u) { if (xb_ld(&bar[XB_TMO])) break; if (sp > XB_SPIN_CAP) { atomicAdd(&bar[XB_TMO], 1u); break; } }
    }
    nloc = mine > 0u ? mine : 1u; nx = cnt > 0u ? cnt : 1u;
}
__device__ __forceinline__ void xcd_barrier(const XcdBarrier& b) {
    asm volatile("s_waitcnt vmcnt(0)" ::: "memory");
    __syncthreads();
    if (threadIdx.x == 0) {
        unsigned* bar = b.bar;
        __builtin_amdgcn_s_waitcnt(0);
        unsigned nloc = b.st[0], nx = b.st[1];
        if (nloc == 0u) { xcd_barrier_complete(bar, b.x, nloc, nx); b.st[0] = nloc; b.st[1] = nx; }
        const unsigned old = xb_add(&bar[XB_XSUB(b.x)], 1u);
        const unsigned gen = old / nloc;
        if (old + 1u == (gen + 1u) * nloc) {
            __builtin_amdgcn_fence(__ATOMIC_RELEASE, "agent");
            asm volatile("s_waitcnt vmcnt(0)" ::: "memory");
            const unsigned og = xb_add(&bar[XB_TOP], 1u);
            const unsigned tg = og / nx;
            if (og + 1u == (tg + 1u) * nx) xb_add(&bar[XB_TOPGEN], 1u);
            else XB_SPIN(xb_ld(&bar[XB_TOPGEN]) == tg, bar);
            __builtin_amdgcn_fence(__ATOMIC_ACQUIRE, "agent");
            xb_add(&bar[XB_XGEN(b.x)], 1u);
            asm volatile("s_waitcnt vmcnt(0)" ::: "memory");
        } else {
            XB_SPIN(xb_ld(&bar[XB_XGEN(b.x)]) == gen, bar);
            __builtin_amdgcn_fence(__ATOMIC_ACQUIRE, "agent");
            asm volatile("s_waitcnt vmcnt(0)" ::: "memory");
        }
    }
    __syncthreads();
}

__device__ __forceinline__ void hier_barrier(unsigned* bar, unsigned round, int wv) {
    asm volatile("s_waitcnt vmcnt(0)" ::: "memory");
    __syncthreads();
    if (wv == 0 && lane_id() == 0) {
        const unsigned G = gridDim.x, grp = blockIdx.x & 7u;
        const unsigned nloc = (G - grp + 7u) >> 3, nx = G < 8u ? G : 8u;
        __builtin_amdgcn_fence(__ATOMIC_RELEASE, "agent");
        asm volatile("s_waitcnt vmcnt(0)" ::: "memory");
        const unsigned old = xb_add(&bar[XB_XSUB(grp)], 1u);
        const unsigned gen = round;
        if (old + 1u == (gen + 1u) * nloc) {
            const unsigned og = xb_add(&bar[XB_TOP], 1u);
            const unsigned tg = round;
            if (og + 1u == (tg + 1u) * nx) xb_add(&bar[XB_TOPGEN], 1u);
            else while (xb_ld(&bar[XB_TOPGEN]) == tg) __builtin_amdgcn_s_sleep(1);
        } else {
            while (xb_ld(&bar[XB_TOPGEN]) == gen) __builtin_amdgcn_s_sleep(1);
        }
        __builtin_amdgcn_fence(__ATOMIC_ACQUIRE, "agent");
        asm volatile("s_waitcnt vmcnt(0)" ::: "memory");
    }
    __syncthreads();
}
__device__ __forceinline__ void simple_barrier(unsigned* cnt, unsigned target) {
    asm volatile("s_waitcnt vmcnt(0)" ::: "memory");
    __syncthreads();
    if (threadIdx.x == 0) {
        __builtin_amdgcn_fence(__ATOMIC_RELEASE, "agent");
        asm volatile("s_waitcnt vmcnt(0)" ::: "memory");
        xb_add(cnt, 1u);
        while (xb_ld(cnt) < target) __builtin_amdgcn_s_sleep(1);
        __builtin_amdgcn_fence(__ATOMIC_ACQUIRE, "agent");
        asm volatile("s_waitcnt vmcnt(0)" ::: "memory");
    }
    __syncthreads();
}

struct ConvTile { const float* src; u16* dst; int N, K; };
__device__ __forceinline__ ConvTile conv_desc(const Params& p, int l, int t, const float* wp0, const float* wp1, const float* wp2) {
  ConvTile c;
  if (t < 1024) { c.src = p.w_in + (size_t)l * 1024 * 4096 + (size_t)((t >> 6) * 64) * 4096 + (t & 63) * 64; c.N = 4096; c.K = 1024; c.dst = p.wt_ig + (size_t)((t & 63) * 64) * 1024 + (t >> 6) * 64; }
  else if (t < 1792) { const int u = t - 1024; const int kt = u / 48, nt = u % 48; c.src = p.w_gate + (size_t)l * 1024 * 3072 + (size_t)(kt * 64) * 3072 + nt * 64; c.N = 3072; c.K = 1024; c.dst = p.wt_ig + (size_t)(4096 + nt * 64) * 1024 + kt * 64; }
  else if (t < 2176) { const int u = t - 1792; const int b = u >> 7, r = u & 127; const int kt = r >> 4, nt = r & 15;
    c.src = (b == 0 ? wp0 : (b == 1 ? wp1 : wp2)) + (size_t)l * 512 * 1024 + (size_t)(kt * 64) * 1024 + nt * 64; c.N = 1024; c.K = 512; c.dst = p.wt_p + ((size_t)b * 1024 + nt * 64) * 512 + kt * 64; }
  else { const int u = t - 2176; const int kt = u >> 4, nt = u & 15; c.src = p.w_out + (size_t)l * 1024 * 1024 + (size_t)(kt * 64) * 1024 + nt * 64; c.N = 1024; c.K = 1024; c.dst = p.wt_o + (size_t)(nt * 64) * 1024 + kt * 64; }
  return c;
}
__device__ __forceinline__ void conv_weights(const Params& p, int l, char* lds, int tid) {
  const float* wp0 = p.w_proj0; const float* wp1 = p.w_proj1; const float* wp2 = p.w_proj2;
  float* tile = (float*)lds;
  const int kk0 = tid >> 4, cc = (tid & 15) * 4;
  const int n = tid >> 3, kc = (tid & 7) * 8;
  int t = blockIdx.x;
  float4 v0 = make_float4(0.f, 0.f, 0.f, 0.f), v1 = v0; ConvTile c = conv_desc(p, l, t < 2432 ? t : 0, wp0, wp1, wp2);
  if (t < 2432) { v0 = *(const float4*)(c.src + (size_t)kk0 * c.N + cc); v1 = *(const float4*)(c.src + (size_t)(kk0 + 32) * c.N + cc); }
  while (t < 2432) {
    const int tn = t + gridDim.x;
    const ConvTile cn = conv_desc(p, l, tn < 2432 ? tn : 0, wp0, wp1, wp2);
    float4 n0 = v0, n1 = v1;
    if (tn < 2432) { n0 = *(const float4*)(cn.src + (size_t)kk0 * cn.N + cc); n1 = *(const float4*)(cn.src + (size_t)(kk0 + 32) * cn.N + cc); }
    __syncthreads();
    { float* tp = tile + kk0 * 65 + cc; tp[0] = v0.x; tp[1] = v0.y; tp[2] = v0.z; tp[3] = v0.w;
      float* tq = tile + (kk0 + 32) * 65 + cc; tq[0] = v1.x; tq[1] = v1.y; tq[2] = v1.z; tq[3] = v1.w; }
    __syncthreads();
    const unsigned w0 = cvtpk(tile[(kc + 0) * 65 + n], tile[(kc + 1) * 65 + n]), w1 = cvtpk(tile[(kc + 2) * 65 + n], tile[(kc + 3) * 65 + n]);
    const unsigned w2 = cvtpk(tile[(kc + 4) * 65 + n], tile[(kc + 5) * 65 + n]), w3 = cvtpk(tile[(kc + 6) * 65 + n], tile[(kc + 7) * 65 + n]);
    *(uint4*)(c.dst + (size_t)n * c.K + kc) = make_uint4(w0, w1, w2, w3);
    v0 = n0; v1 = n1; c = cn; t = tn;
  }
  __syncthreads();
}

__device__ __forceinline__ void phase_pre(const Params& p, char* lds, int wv) {
  const int tid = opaque_tid(wv), lane = tid & 63, wid = tid >> 6;
  const int gtid = blockIdx.x * NTHR + tid, gsz = gridDim.x * NTHR;
  for (int i = gtid; i < 1024; i += gsz) {
    const int pos = i >> 4, f = i & 15;
    const float inv = exp2f(-(float)f * 0.8304820237218406f);
    const float a = (float)pos * inv;
    p.rope[i] = __cosf(a); p.rope[1024 + i] = __sinf(a);
  }
  const float* c0 = p.cache0; const float* c1 = p.cache1; const float* c2 = p.cache2; const float* c3 = p.cache3;
  for (int i = gtid; i < 4 * 65536; i += gsz) {
    const int t = i >> 16; const int o = (i & 65535) * 8;
    const float* cs = t == 0 ? c0 : (t == 1 ? c1 : (t == 2 ? c2 : c3));
    const float4* s = (const float4*)(cs + o); const float4 a = s[0], b = s[1];
    *(uint4*)(p.cachebf + (size_t)t * 524288 + o) = make_uint4(cvtpk(a.x, a.y), cvtpk(a.z, a.w), cvtpk(b.x, b.y), cvtpk(b.z, b.w));
  }
  for (int i = gtid; i < 32768; i += gsz) {
    const float4* s = (const float4*)(p.w_spatial + (size_t)i * 8); const float4 a = s[0], b = s[1];
    *(uint4*)(p.wsp + (size_t)i * 8) = make_uint4(cvtpk(a.x, a.y), cvtpk(a.z, a.w), cvtpk(b.x, b.y), cvtpk(b.z, b.w));
  }
  float* red = (float*)lds;
  for (int task = blockIdx.x; task < 192; task += gridDim.x) {
    const int l = task / 48, n0 = (task % 48) * 64;
    const float* W = p.w_mod + (size_t)l * 1024 * 3072 + n0 + lane;
    float a0 = 0.f, a1 = 0.f, a2 = 0.f;
#pragma unroll 16
    for (int k = wid * 128; k < wid * 128 + 128; ++k) {
      const float w = W[(size_t)k * 3072];
      a0 += silu_f(p.c[k]) * w; a1 += silu_f(p.c[1024 + k]) * w; a2 += silu_f(p.c_ctx[k]) * w;
    }
    __syncthreads();
    red[(wid * 3 + 0) * 64 + lane] = a0; red[(wid * 3 + 1) * 64 + lane] = a1; red[(wid * 3 + 2) * 64 + lane] = a2;
    __syncthreads();
    if (wid < 3) {
      float s = 0.f;
#pragma unroll
      for (int w = 0; w < 8; ++w) s += red[(w * 3 + wid) * 64 + lane];
      p.mod[(l * 3 + wid) * 3072 + n0 + lane] = s + p.b_mod[l * 3072 + n0 + lane];
    }
  }
  conv_weights(p, 0, lds, tid);
}

__device__ __forceinline__ void phase_row(const Params& p, int l, char* lds, int wv) {
  const int tid = opaque_tid(wv), lane = tid & 63, wid = tid >> 6;
  const int rstride = gridDim.x * NWAVE;
  for (int row0 = blockIdx.x * NWAVE + wid; row0 < NTOK; row0 += 2 * rstride) {
    f32x4 v[2][4];
#pragma unroll
    for (int u = 0; u < 2; ++u) {
      const int row = row0 + u * rstride;
      if (row < NTOK) {
        const float* src = (l == 0) ? (row < NCTX ? p.x_prompt + (size_t)row * 1024 : p.x_sample + (size_t)(row - NCTX) * 1024) : p.out + (size_t)row * 1024;
#pragma unroll
        for (int j = 0; j < 4; ++j) v[u][j] = *(const f32x4*)(src + j * 256 + lane * 4);
      }
    }
#pragma unroll
    for (int u = 0; u < 2; ++u) {
      const int row = row0 + u * rstride;
      if (row < NTOK) {
        if (l > 0) {
          float s = 0.f;
#pragma unroll
          for (int j = 0; j < 4; ++j) s += v[u][j][0] + v[u][j][1] + v[u][j][2] + v[u][j][3];
          const float mean = wave_sum(s) * (1.f / 1024.f);
          float q = 0.f;
#pragma unroll
          for (int j = 0; j < 4; ++j) { v[u][j] -= mean; q += v[u][j][0] * v[u][j][0] + v[u][j][1] * v[u][j][1] + v[u][j][2] * v[u][j][2] + v[u][j][3] * v[u][j][3]; }
          const float rstd = rsqrtf(wave_sum(q) * (1.f / 1024.f) + LN_EPS);
#pragma unroll
          for (int j = 0; j < 4; ++j) {
            const f32x4 g = *(const f32x4*)(p.ln_g + (l - 1) * 1024 + j * 256 + lane * 4), b = *(const f32x4*)(p.ln_b + (l - 1) * 1024 + j * 256 + lane * 4);
            v[u][j] = v[u][j] * rstd * g + b;
            *(f32x4*)(p.out + (size_t)row * 1024 + j * 256 + lane * 4) = v[u][j];
          }
        }
        if (l < 4) {
          float s = 0.f;
#pragma unroll
          for (int j = 0; j < 4; ++j) s += v[u][j][0] + v[u][j][1] + v[u][j][2] + v[u][j][3];
          const float mean = wave_sum(s) * (1.f / 1024.f);
          float q = 0.f;
#pragma unroll
          for (int j = 0; j < 4; ++j) { v[u][j] -= mean; q += v[u][j][0] * v[u][j][0] + v[u][j][1] * v[u][j][1] + v[u][j][2] * v[u][j][2] + v[u][j][3] * v[u][j][3]; }
          const float rstd = rsqrtf(wave_sum(q) * (1.f / 1024.f) + LN_EPS);
          const int mv = row < NCTX ? 2 : ((row - NCTX) >> 11);
          const float* md = p.mod + (l * 3 + mv) * 3072;
#pragma unroll
          for (int j = 0; j < 4; ++j) {
            const f32x4 sh = *(const f32x4*)(md + j * 256 + lane * 4), sc = *(const f32x4*)(md + 1024 + j * 256 + lane * 4);
            const f32x4 h = v[u][j] * rstd * (1.f + sc) + sh;
            *(uint2*)(p.H + (size_t)row * 1024 + j * 256 + lane * 4) = make_uint2(cvtpk(h[0], h[1]), cvtpk(h[2], h[3]));
          }
        }
      }
    }
  }
  if (l > 0 && l < 4) conv_weights(p, l, lds, tid);
}

constexpr int G_BK = 64, G_HALF = 128, G_HTB = G_HALF * G_BK * 2;
__device__ __forceinline__ int lds_byte(int r, int c) { const int st = (r >> 4) * 2 + (c >> 5), rr = r & 15, cc = c & 31, ob = rr * 64 + cc * 2; return st * 1024 + (ob ^ (((ob >> 9) & 1) << 5)); }
__device__ __forceinline__ void stage_rc(int b, int& R, int& C) { const int st = b / 1024, sb = b % 1024, swz = sb ^ (((sb >> 9) & 1) << 5); R = (st >> 1) * 16 + swz / 64; C = (st & 1) * 32 + (swz % 64) / 2; }
struct Unit { const char* a; const char* b; int pm, pn, aux; };

template <class Epi, class Sched>
__device__ __forceinline__ void gemm_phase(LAS unsigned char* lds, const int K, const int lda, const int ldb, const Sched& S, const Epi& E, const int tid) {
    const int wid = __builtin_amdgcn_readfirstlane(tid >> 6), lane = tid & 63, wr = wid >> 2, wc = wid & 3, fr = lane & 15, fq = lane >> 4;
    const int nt = K / G_BK;
    unsigned voffA[2], voffB[2];
#pragma unroll
    for (int i = 0; i < 2; ++i) { int R, C; stage_rc(tid * 16 + i * 8192, R, C); const int rho = R & 63, Ra = (R & ~63) + 32 * (rho >> 5) + 8 * ((rho >> 2) & 3) + 4 * ((rho >> 4) & 1) + (rho & 3);
        voffA[i] = (unsigned)(Ra * lda + C) * 2u; voffB[i] = (unsigned)(R * ldb + C) * 2u; }
    const size_t kstep = (size_t)(G_BK * 2);
    const size_t hstepA = (size_t)G_HALF * lda * 2, hstepB = (size_t)G_HALF * ldb * 2;
    const unsigned ldsw = (unsigned)wid * 1024u;
    const int aoff = lds_byte(wr * 64 + fr, fq * 8), boff = lds_byte(wc * 32 + fr, fq * 8);
#define PG8_SA(b, h) (((b) * 2 + (h)) * G_HTB)
#define PG8_SB(b, h) ((4 + (b) * 2 + (h)) * G_HTB)
#define PG8_STAGE(bufoff, gbase, voff) do { _Pragma("unroll") for (int _i = 0; _i < 2; ++_i) \
        __builtin_amdgcn_global_load_lds((const unsigned*)((const char*)(gbase) + (voff)[_i]), (LAS unsigned*)(lds + (bufoff) + ldsw + _i * 8192), 16, 0, 0); } while (0)
#define PG8_LDA(dst, b, h) do { _Pragma("unroll") for (int m = 0; m < 4; ++m) _Pragma("unroll") for (int k = 0; k < 2; ++k) dst[m][k] = *(const LAS bf16x8*)(lds + PG8_SA(b, h) + aoff + m * 2048 + k * 1024); } while (0)
#define PG8_LDB(dst, b, h) do { _Pragma("unroll") for (int n = 0; n < 2; ++n) _Pragma("unroll") for (int k = 0; k < 2; ++k) dst[n][k] = *(const LAS bf16x8*)(lds + PG8_SB(b, h) + boff + n * 2048 + k * 1024); } while (0)
#define PG8_MMA(ai, bj, At, Bt) do { __builtin_amdgcn_s_setprio(1); _Pragma("unroll") for (int m = 0; m < 4; ++m) _Pragma("unroll") for (int n = 0; n < 2; ++n) _Pragma("unroll") for (int k = 0; k < 2; ++k) \
        acc[ai][bj][m][n] = __builtin_amdgcn_mfma_f32_16x16x32_bf16(At[m][k], Bt[n][k], acc[ai][bj][m][n], 0, 0, 0); __builtin_amdgcn_s_setprio(0); } while (0)
#define PG8_WAIT_V(n) asm volatile("s_waitcnt vmcnt(" #n ")" ::: "memory")
#define PG8_WAIT_L(n) asm volatile("s_waitcnt lgkmcnt(" #n ")" ::: "memory")
#define PG8_BAR __builtin_amdgcn_s_barrier()
#define PG8_SCHED __builtin_amdgcn_sched_barrier(0)
    Unit cur, nxt; int ui = 0;
    if (!S.next(0, cur)) return;
    f32x4_t acc[2][2][4][2];
#pragma unroll
    for (int a = 0; a < 2; ++a)
#pragma unroll
        for (int b = 0; b < 2; ++b)
#pragma unroll
            for (int m = 0; m < 4; ++m)
#pragma unroll
                for (int n = 0; n < 2; ++n) acc[a][b][m][n] = (f32x4_t){0.f, 0.f, 0.f, 0.f};
    bf16x8 At[4][2], B0[2][2], B1[2][2];
    const char* cA = cur.a; const char* cB = cur.b;
    PG8_STAGE(PG8_SB(0, 0), cB, voffB); PG8_STAGE(PG8_SA(0, 0), cA, voffA); PG8_STAGE(PG8_SB(0, 1), cB + hstepB, voffB); PG8_STAGE(PG8_SA(0, 1), cA + hstepA, voffA);
    if (wr == 1) PG8_BAR;
    PG8_WAIT_V(4); PG8_BAR;
    PG8_STAGE(PG8_SB(1, 0), cB + kstep, voffB); PG8_STAGE(PG8_SA(1, 0), cA + kstep, voffA); PG8_STAGE(PG8_SB(1, 1), cB + hstepB + kstep, voffB);
    PG8_WAIT_V(6); PG8_BAR;
    for (;;) {
        const bool has_next = S.next(ui + 1, nxt);
        const char* nA = has_next ? nxt.a : cA; const char* nB = has_next ? nxt.b : cB;
        for (int t = 0; t < nt; t += 2) {
            const bool last = (t == nt - 2);
            const char* a1 = cA + (size_t)(t + 1) * kstep;
            const char* a2 = last ? nA : cA + (size_t)(t + 2) * kstep; const char* b2 = last ? nB : cB + (size_t)(t + 2) * kstep;
            const char* a3 = a2 + kstep; const char* b3 = b2 + kstep;
            PG8_LDB(B0, 0, 0); PG8_SCHED; PG8_LDA(At, 0, 0); PG8_STAGE(PG8_SA(1, 1), a1 + hstepA, voffA);
            PG8_WAIT_L(8); PG8_BAR; PG8_WAIT_L(0); PG8_MMA(0, 0, At, B0); PG8_BAR; PG8_SCHED;
            PG8_LDB(B1, 0, 1); PG8_STAGE(PG8_SB(0, 0), b2, voffB);
            PG8_BAR; PG8_WAIT_L(0); PG8_MMA(0, 1, At, B1); PG8_BAR;
            PG8_LDA(At, 0, 1); PG8_STAGE(PG8_SA(0, 0), a2, voffA);
            PG8_BAR; PG8_WAIT_L(0); PG8_MMA(1, 0, At, B0); PG8_BAR; PG8_SCHED;
            PG8_STAGE(PG8_SB(0, 1), b2 + hstepB, voffB);
            PG8_WAIT_V(6); PG8_BAR; PG8_MMA(1, 1, At, B1); PG8_BAR;
            PG8_LDB(B0, 1, 0); PG8_SCHED; PG8_LDA(At, 1, 0); PG8_STAGE(PG8_SA(0, 1), a2 + hstepA, voffA);
            PG8_WAIT_L(8); PG8_BAR; PG8_WAIT_L(0); PG8_MMA(0, 0, At, B0); PG8_BAR; PG8_SCHED;
            PG8_LDB(B1, 1, 1); PG8_STAGE(PG8_SB(1, 0), b3, voffB);
            PG8_BAR; PG8_WAIT_L(0); PG8_MMA(0, 1, At, B1); PG8_BAR;
            PG8_LDA(At, 1, 1); PG8_STAGE(PG8_SA(1, 0), a3, voffA);
            PG8_BAR; PG8_WAIT_L(0); PG8_MMA(1, 0, At, B0); PG8_BAR; PG8_SCHED;
            PG8_STAGE(PG8_SB(1, 1), b3 + hstepB, voffB);
            PG8_WAIT_V(6); PG8_BAR; PG8_MMA(1, 1, At, B1); PG8_BAR;
        }
        E(acc, cur, wid, wr, wc, fr, fq, lane);
        if (!has_next) break;
        if (!E.keep_acc(cur)) {
#pragma unroll
        for (int a = 0; a < 2; ++a)
#pragma unroll
            for (int b = 0; b < 2; ++b)
#pragma unroll
                for (int m = 0; m < 4; ++m)
#pragma unroll
                    for (int n = 0; n < 2; ++n) acc[a][b][m][n] = (f32x4_t){0.f, 0.f, 0.f, 0.f};
        }
        cur = nxt; cA = nA; cB = nB; ++ui;
    }
    PG8_WAIT_V(0);
    if (wr == 0) PG8_BAR;
    PG8_BAR;
#undef PG8_SA
#undef PG8_SB
#undef PG8_STAGE
#undef PG8_LDA
#undef PG8_LDB
#undef PG8_MMA
#undef PG8_WAIT_V
#undef PG8_WAIT_L
#undef PG8_BAR
#undef PG8_SCHED
}

__device__ __forceinline__ void tile_of(int L, int nM, int nN, int& pm, int& pn) {
  const int nwg = nM * nN;
  int wgid = L; { const int q = nwg / 8, r = nwg % 8, xcd = wgid % 8, off = wgid / 8; wgid = (xcd < r ? xcd * (q + 1) : r * (q + 1) + (xcd - r) * q) + off; }
  const int nig = 8 * nN, gid = wgid / nig, fm = gid * 8, gsz = (nM - fm) < 8 ? (nM - fm) : 8;
  pm = fm + ((wgid % nig) % gsz); pn = (wgid % nig) / gsz;
}

struct SchedP2 {
  const char* A; const char* B; int G, c;
  __device__ __forceinline__ bool next(int i, Unit& u) const {
    const int L = i * G + c; if (L >= 16 * 48) return false;
    tile_of(L, 16, 48, u.pm, u.pn); u.aux = 0;
    u.pm = (u.pm & 8) | ((u.pm + 3 * i) & 7);
    u.pm = (u.pm & 1) * 8 + (u.pm >> 1);
    u.pn = (u.pn & 3) * 12 + (u.pn >> 2);
    u.a = A + (size_t)u.pm * 256 * 1024 * 2; u.b = B + (size_t)u.pn * 256 * 1024 * 2; return true;
  }
};
struct EpiP2 {
  __device__ __forceinline__ bool keep_acc(const Unit&) const { return false; }
  const float* b_gate; const float* q_norm; const float* k_norm; const float* rope; float* so; u16* P; u16* G; int l;
  __device__ __forceinline__ void operator()(f32x4_t (&acc)[2][2][4][2], const Unit& u, int wid, int wr, int wc, int fr, int fq, int lane) const {
    const int f0 = u.pm * 256, t0 = u.pn * 256;
    const bool lat = t0 >= NCTX;
#pragma unroll
    for (int ai = 0; ai < 2; ++ai) {
      const int fb = f0 + 128 * ai + 64 * wr;
      int norm = 0, kvh = 0; bool rp = false, act = false; float scl = 1.f; float* st = nullptr;
      if (fb < 512) { norm = 1; rp = lat; scl = 0.18033688011112042f; }
      else if (fb < 640) { norm = 2; rp = lat; kvh = (fb - 512) >> 6; if (!lat) st = so; }
      else if (fb < 768) { kvh = (fb - 640) >> 6; if (!lat) st = so + 4194304; }
      else if (fb < 1280) { act = true; }
      else if (fb < 1792) { rp = lat; scl = 0.18033688011112042f; }
      else if (fb < 1920) { rp = lat; kvh = (fb - 1792) >> 6; if (!lat) st = so + 2 * 4194304; }
      else if (fb < 2048) { kvh = (fb - 1920) >> 6; if (!lat) st = so + 3 * 4194304; }
      else if (fb < 2560) { act = true; }
      else if (fb < 3584) { }
      else { act = true; }
      if (norm) {
        f32x4_t gn[4];
#pragma unroll
        for (int m = 0; m < 4; ++m) {
          const int dd = 32 * (m >> 1) + 8 * fq + 4 * (m & 1);
          const f32x4_t gq = *(const f32x4_t*)(q_norm + l * 64 + dd), gk = *(const f32x4_t*)(k_norm + l * 64 + dd);
          gn[m] = norm == 1 ? gq : gk;
        }
#pragma unroll
        for (int bj = 0; bj < 2; ++bj)
#pragma unroll
          for (int n = 0; n < 2; ++n) {
            float ss = 0.f;
#pragma unroll
            for (int m = 0; m < 4; ++m) { const f32x4_t x = acc[ai][bj][m][n]; ss += x[0] * x[0] + x[1] * x[1] + x[2] * x[2] + x[3] * x[3]; }
            ss += __shfl_xor(ss, 16); ss += __shfl_xor(ss, 32);
            const float rs = rsqrtf(ss * (1.f / 64.f) + LN_EPS);
#pragma unroll
            for (int m = 0; m < 4; ++m) acc[ai][bj][m][n] = acc[ai][bj][m][n] * rs * gn[m];
          }
      }
      if (st) {
#pragma unroll
        for (int bj = 0; bj < 2; ++bj)
#pragma unroll
          for (int n = 0; n < 2; ++n) {
            const int token = t0 + 128 * bj + 32 * wc + 16 * n + fr;
            float* o = st + ((size_t)((token >> 8) * 4 + l) * 256 + (token & 255)) * 128 + kvh * 64 + 8 * fq;
#pragma unroll
            for (int m = 0; m < 4; ++m) *(f32x4_t*)(o + 32 * (m >> 1) + 4 * (m & 1)) = acc[ai][bj][m][n];
          }
      }
      if (rp) {
#pragma unroll
        for (int bj = 0; bj < 2; ++bj) {
          f32x4_t c4[2][2], s4[2][2];
#pragma unroll
          for (int n = 0; n < 2; ++n) {
            const int token = t0 + 128 * bj + 32 * wc + 16 * n + fr;
            const int nn = (token - NCTX) & 2047;
            const int pos = fq < 2 ? (nn >> 6) : (nn & 63);
#pragma unroll
            for (int m = 0; m < 2; ++m) {
              const int fo = pos * 16 + 8 * (fq & 1) + 4 * m;
              c4[n][m] = *(const f32x4_t*)(rope + fo); s4[n][m] = *(const f32x4_t*)(rope + 1024 + fo);
            }
          }
#pragma unroll
          for (int n = 0; n < 2; ++n)
#pragma unroll
            for (int m = 0; m < 2; ++m) {
              const f32x4_t x1 = acc[ai][bj][m][n], x2 = acc[ai][bj][m + 2][n];
              acc[ai][bj][m][n] = x1 * c4[n][m] - x2 * s4[n][m]; acc[ai][bj][m + 2][n] = x2 * c4[n][m] + x1 * s4[n][m];
            }
        }
      }
#pragma unroll
      for (int bj = 0; bj < 2; ++bj)
#pragma unroll
        for (int n = 0; n < 2; ++n) {
          const int token = t0 + 128 * bj + 32 * wc + 16 * n + fr;
          u16* dp = P + (size_t)token * LDP + fb + 8 * fq;
#pragma unroll
          for (int mp = 0; mp < 2; ++mp) {
            f32x4_t y0 = acc[ai][bj][2 * mp][n] * scl, y1 = acc[ai][bj][2 * mp + 1][n] * scl;
            if (act) { y0[0] = silu_f(y0[0]); y0[1] = silu_f(y0[1]); y0[2] = silu_f(y0[2]); y0[3] = silu_f(y0[3]); y1[0] = silu_f(y1[0]); y1[1] = silu_f(y1[1]); y1[2] = silu_f(y1[2]); y1[3] = silu_f(y1[3]); }
            *(uint4*)(dp + 32 * mp) = make_uint4(cvtpk(y0[0], y0[1]), cvtpk(y0[2], y0[3]), cvtpk(y1[0], y1[1]), cvtpk(y1[2], y1[3]));
          }
        }
    }
  }
};

struct EpiGate {
  __device__ __forceinline__ bool keep_acc(const Unit&) const { return false; }
  const float* b_gate; u16* G; int l;
  __device__ __forceinline__ void operator()(f32x4_t (&acc)[2][2][4][2], const Unit& u, int wid, int wr, int wc, int fr, int fq, int lane) const {
    const int f0 = u.pm * 256;
    if (f0 >= 4096) {
      const int ug = (u.pm - 16) * 48 + u.pn;
      uint4* dst = (uint4*)G + ((size_t)(ug * 8 + wid) * 16) * 64 + lane;
#pragma unroll
      for (int ai = 0; ai < 2; ++ai)
#pragma unroll
        for (int m = 0; m < 4; ++m) {
          const f32x4_t bv = *(const f32x4_t*)(b_gate + l * 3072 + (f0 - 4096) + 128 * ai + 64 * wr + 32 * (m >> 1) + 8 * fq + 4 * (m & 1));
#pragma unroll
          for (int bj = 0; bj < 2; ++bj)
#pragma unroll
            for (int n = 0; n < 2; ++n) {
              f32x4_t x = acc[ai][bj][m][n] + bv;
              x[0] = sigmoid_f(x[0]); x[1] = sigmoid_f(x[1]); x[2] = sigmoid_f(x[2]); x[3] = sigmoid_f(x[3]);
              acc[ai][bj][m][n] = x;
            }
        }
#pragma unroll
      for (int ai = 0; ai < 2; ++ai)
#pragma unroll
        for (int m = 0; m < 4; ++m)
#pragma unroll
          for (int bj = 0; bj < 2; ++bj) {
            const f32x4_t x0 = acc[ai][bj][m][0], x1 = acc[ai][bj][m][1];
            dst[((ai * 2 + bj) * 4 + m) * 64] = make_uint4(cvtpk(x0[0], x0[1]), cvtpk(x0[2], x0[3]), cvtpk(x1[0], x1[1]), cvtpk(x1[2], x1[3]));
          }
    }
  }
};

struct SchedGate {
  const char* A; const char* B; int item;
  __device__ __forceinline__ bool next(int i, Unit& u) const {
    if (i >= 2) return false;
    const int g = item * 2 + i; u.pm = 16 + g / 48; u.pn = g % 48; u.aux = 0;
    u.a = A + (size_t)u.pm * 256 * 1024 * 2; u.b = B + (size_t)u.pn * 256 * 1024 * 2; return true;
  }
};

struct SchedP4 {
  const char* A; const char* B; int c;
  __device__ __forceinline__ bool next(int i, Unit& u) const {
    if (c >= 192 || i >= 3) return false;
    tile_of(c, 4, 48, u.pm, u.pn); u.aux = i;
    u.a = A + ((size_t)i * 1024 + (size_t)u.pm * 256) * 512 * 2;
    u.b = B + ((size_t)u.pn * 256 * LDP + (i == 0 ? 0 : (i == 1 ? 1280 : 2560))) * 2; return true;
  }
};
struct EpiP4 {
  const u16* G; u16* Z;
  __device__ __forceinline__ bool keep_acc(const Unit& u) const { return u.aux < 2; }
  __device__ __forceinline__ void operator()(f32x4_t (&acc)[2][2][4][2], const Unit& u, int wid, int wr, int wc, int fr, int fq, int lane) const {
    const int br = u.aux;
    const uint4* gs = (const uint4*)G + ((size_t)(((br * 4 + u.pm) * 48 + u.pn) * 8 + wid) * 16) * 64 + lane;
    const uint4* gn = gs + (size_t)4 * 48 * 8 * 16 * 64;
#pragma unroll
    for (int ai = 0; ai < 2; ++ai)
#pragma unroll
    for (int bj = 0; bj < 2; ++bj) {
      uint4 gc[4], gx[4];
#pragma unroll
      for (int m = 0; m < 4; ++m) gc[m] = gs[((ai * 2 + bj) * 4 + m) * 64];
      if (br < 2) {
#pragma unroll
        for (int m = 0; m < 4; ++m) gx[m] = gn[((ai * 2 + bj) * 4 + m) * 64];
      }
#pragma unroll
      for (int m = 0; m < 4; ++m) {
          const uint4 g = gc[m];
          f32x4_t c0, c1;
          c0[0] = bflo(g.x); c0[1] = bfhi(g.x); c0[2] = bflo(g.y); c0[3] = bfhi(g.y);
          c1[0] = bflo(g.z); c1[1] = bfhi(g.z); c1[2] = bflo(g.w); c1[3] = bfhi(g.w);
          if (br > 0) {
#pragma unroll
            for (int j = 0; j < 4; ++j) { c0[j] = fmaxf(c0[j], 1e-30f); c1[j] = fmaxf(c1[j], 1e-30f); }
          }
          if (br < 2) {
            const uint4 h = gx[m];
            c0[0] *= __builtin_amdgcn_rcpf(fmaxf(bflo(h.x), 1e-30f)); c0[1] *= __builtin_amdgcn_rcpf(fmaxf(bfhi(h.x), 1e-30f)); c0[2] *= __builtin_amdgcn_rcpf(fmaxf(bflo(h.y), 1e-30f)); c0[3] *= __builtin_amdgcn_rcpf(fmaxf(bfhi(h.y), 1e-30f));
            c1[0] *= __builtin_amdgcn_rcpf(fmaxf(bflo(h.z), 1e-30f)); c1[1] *= __builtin_amdgcn_rcpf(fmaxf(bfhi(h.z), 1e-30f)); c1[2] *= __builtin_amdgcn_rcpf(fmaxf(bflo(h.w), 1e-30f)); c1[3] *= __builtin_amdgcn_rcpf(fmaxf(bfhi(h.w), 1e-30f));
            acc[ai][bj][m][0] *= c0; acc[ai][bj][m][1] *= c1;
          } else {
            acc[ai][bj][m][0] *= c0; acc[ai][bj][m][1] *= c1;
          }
      }
      if (br == 2) {
        const int tk = u.pn * 256 + 128 * bj + 32 * wc + fr;
        u16* zp = Z + (size_t)tk * 1024 + u.pm * 256 + 128 * ai + 64 * wr + 8 * fq;
#pragma unroll
        for (int mp = 0; mp < 2; ++mp) {
          const f32x4_t a0 = acc[ai][bj][2 * mp][0], a1 = acc[ai][bj][2 * mp + 1][0], b0 = acc[ai][bj][2 * mp][1], b1 = acc[ai][bj][2 * mp + 1][1];
          *(uint4*)(zp + 32 * mp) = make_uint4(cvtpk(a0[0], a0[1]), cvtpk(a0[2], a0[3]), cvtpk(a1[0], a1[1]), cvtpk(a1[2], a1[3]));
          *(uint4*)(zp + 16 * 1024 + 32 * mp) = make_uint4(cvtpk(b0[0], b0[1]), cvtpk(b0[2], b0[3]), cvtpk(b1[0], b1[1]), cvtpk(b1[2], b1[3]));
        }
      }
    }
  }
};

struct SchedP5 {
  const char* A; const char* B; int c;
  __device__ __forceinline__ bool next(int i, Unit& u) const {
    if (c >= 192 || i >= 1) return false;
    tile_of(c, 4, 48, u.pm, u.pn); u.aux = 0;
    u.a = A + (size_t)u.pm * 256 * 1024 * 2; u.b = B + (size_t)u.pn * 256 * 1024 * 2; return true;
  }
};
struct EpiP5 {
  const float* mod; const float* xp; const float* xs; float* out; int l;
  __device__ __forceinline__ bool keep_acc(const Unit&) const { return false; }
  __device__ __forceinline__ void operator()(f32x4_t (&acc)[2][2][4][2], const Unit& u, int wid, int wr, int wc, int fr, int fq, int lane) const {
    const int t0 = u.pn * 256;
    const int mv = t0 < NCTX ? 2 : ((t0 - NCTX) >> 11);
    const float* gt = mod + (l * 3 + mv) * 3072 + 2048 + u.pm * 256 + 64 * wr + 8 * fq;
    f32x4_t gv[2][4];
#pragma unroll
    for (int ai = 0; ai < 2; ++ai)
#pragma unroll
      for (int m = 0; m < 4; ++m) gv[ai][m] = *(const f32x4_t*)(gt + 128 * ai + 32 * (m >> 1) + 4 * (m & 1));
#pragma unroll
    for (int bj = 0; bj < 2; ++bj)
#pragma unroll
      for (int n = 0; n < 2; ++n) {
        const int token = t0 + 128 * bj + 32 * wc + 16 * n + fr;
        const float* xsrc = ((l == 0) ? (token < NCTX ? xp + (size_t)token * 1024 : xs + (size_t)(token - NCTX) * 1024) : out + (size_t)token * 1024) + u.pm * 256 + 64 * wr + 8 * fq;
        float* od = out + (size_t)token * 1024 + u.pm * 256 + 64 * wr + 8 * fq;
        f32x4_t xv[2][4];
#pragma unroll
        for (int ai = 0; ai < 2; ++ai)
#pragma unroll
          for (int m = 0; m < 4; ++m) xv[ai][m] = *(const f32x4_t*)(xsrc + 128 * ai + 32 * (m >> 1) + 4 * (m & 1));
#pragma unroll
        for (int ai = 0; ai < 2; ++ai)
#pragma unroll
          for (int m = 0; m < 4; ++m) *(f32x4_t*)(od + 128 * ai + 32 * (m >> 1) + 4 * (m & 1)) = ALPHA * xv[ai][m] + gv[ai][m] * acc[ai][bj][m][n];
      }
  }
};

__device__ __forceinline__ void attn_item(u16* Qp, const u16* Gp,
                          const u16* K0, const u16* V0, int ld0, int n0, bool masked, int kpos0, int qpos0,
                          const u16* K1, const u16* V1, int ld1, int n1, bool has_sink, float sink, char* lds, int tid_in) {
  int tid = tid_in; asm volatile("" : "+v"(tid));
  const int lane = tid & 63, wid = tid >> 6, r32 = lane & 31, hi = lane >> 5;
  bf16x8 qr[4];
#pragma unroll
  for (int d0 = 0; d0 < 4; ++d0) qr[d0] = *(const bf16x8*)(Qp + (size_t)(wid * 32 + r32) * LDP + d0 * 16 + hi * 8);
  const int np0 = n0 >> 7, NI = np0 + (n1 >> 7);
  uint4 kr0, kr1, vr0, vr1;
#define ATT_GLOAD(i_) do { const int i__ = (i_); const u16 *kp, *vp; int ld; \
    if (i__ < np0) { kp = K0 + (size_t)i__ * 128 * ld0; vp = V0 + (size_t)i__ * 128 * ld0; ld = ld0; } \
    else { kp = K1 + (size_t)(i__ - np0) * 128 * ld1; vp = V1 + (size_t)(i__ - np0) * 128 * ld1; ld = ld1; } \
    kr0 = *(const uint4*)(kp + (size_t)(tid >> 3) * ld + (tid & 7) * 8); \
    kr1 = *(const uint4*)(kp + (size_t)(64 + (tid >> 3)) * ld + (tid & 7) * 8); \
    vr0 = *(const uint4*)(vp + (size_t)((tid & 255) >> 2) * ld + (tid >> 8) * 32 + (tid & 3) * 8); \
    vr1 = *(const uint4*)(vp + (size_t)(64 + ((tid & 255) >> 2)) * ld + (tid >> 8) * 32 + (tid & 3) * 8); } while (0)
#define ATT_LWRITE(buf_) do { const int b__ = (buf_); \
    *(uint4*)(lds + b__ * 18432 + (tid >> 3) * 144 + (tid & 7) * 16) = kr0; \
    *(uint4*)(lds + b__ * 18432 + 9216 + (tid >> 3) * 144 + (tid & 7) * 16) = kr1; \
    *(uint4*)(lds + 36864 + b__ * 16384 + tid * 16) = vr0; \
    *(uint4*)(lds + 36864 + b__ * 16384 + 8192 + tid * 16) = vr1; } while (0)
  f32x16 o[2];
#pragma unroll
  for (int r = 0; r < 16; ++r) { o[0][r] = 0.f; o[1][r] = 0.f; }
  float m = -1e30f, lsum = 0.f;
  const int qpos = qpos0 + wid * 32 + r32;
  const int vlane = ((lane >> 4) & 1) * 32 + (lane & 3) * 8 + (4 * hi + ((lane & 15) >> 2)) * 64;
#define ATT_MASK(sa, sb, tt_) do { const int kb0 = kpos0 + (tt_) * 64 + 4 * hi; \
      _Pragma("unroll") for (int r = 0; r < 16; ++r) { \
        const int kp = kb0 + (r & 3) + 8 * (r >> 2); \
        int e0 = qpos - kp; e0 = e0 < 0 ? -e0 : e0; \
        int e1 = qpos - kp - 32; e1 = e1 < 0 ? -e1 : e1; \
        if (e0 > 128) sa[r] = -1e30f; \
        if (e1 > 128) sb[r] = -1e30f; } } while (0)
#define ATT_PACK(sx, h_) __builtin_bit_cast(bf16x8, make_uint4(cvtpk(sx[8 * (h_) + 0], sx[8 * (h_) + 1]), cvtpk(sx[8 * (h_) + 2], sx[8 * (h_) + 3]), cvtpk(sx[8 * (h_) + 4], sx[8 * (h_) + 5]), cvtpk(sx[8 * (h_) + 6], sx[8 * (h_) + 7])))
#define ATT_PV1(vb_, off_, pf_) do { \
    _Pragma("unroll") for (int db = 0; db < 2; ++db) { \
      const lds_cptr vp_ = (vb_) + db * 4096 + (off_) * 64; \
      const s16x4 lo_ = vtr(vp_), hh_ = vtr(vp_ + 512); \
      const bf16x8 vf_ = (bf16x8){lo_[0], lo_[1], lo_[2], lo_[3], hh_[0], hh_[1], hh_[2], hh_[3]}; \
      o[db] = MFMA(vf_, pf_, o[db]); } } while (0)
  ATT_GLOAD(0); ATT_LWRITE(0);
  __syncthreads();
  for (int i = 0; i < NI; ++i) {
    const int buf = i & 1;
    if (i + 1 < NI) ATT_GLOAD(i + 1);
    const char* kb_ = lds + buf * 18432 + r32 * 144 + hi * 16;
    f32x16 s0, s1, s2, s3;
#pragma unroll
    for (int r = 0; r < 16; ++r) { s0[r] = 0.f; s1[r] = 0.f; s2[r] = 0.f; s3[r] = 0.f; }
#pragma unroll
    for (int d0 = 0; d0 < 4; ++d0) {
      const bf16x8 k0 = *(const bf16x8*)(kb_ + d0 * 32), k1 = *(const bf16x8*)(kb_ + 32 * 144 + d0 * 32);
      const bf16x8 k2 = *(const bf16x8*)(kb_ + 9216 + d0 * 32), k3 = *(const bf16x8*)(kb_ + 9216 + 32 * 144 + d0 * 32);
      s0 = MFMA(k0, qr[d0], s0); s1 = MFMA(k1, qr[d0], s1); s2 = MFMA(k2, qr[d0], s2); s3 = MFMA(k3, qr[d0], s3);
    }
    if (masked && i < np0) { ATT_MASK(s0, s1, 2 * i); ATT_MASK(s2, s3, 2 * i + 1); }
    float mx = fmaxf(fmaxf(s0[0], s1[0]), fmaxf(s2[0], s3[0]));
#pragma unroll
    for (int r = 1; r < 16; ++r) mx = fmaxf(mx, fmaxf(fmaxf(s0[r], s1[r]), fmaxf(s2[r], s3[r])));
    mx = fmaxf(mx, __shfl_xor(mx, 32));
    if (__any(mx > m)) {
      const float mn = fmaxf(m, mx); const float alpha = __builtin_amdgcn_exp2f(m - mn); m = mn; lsum *= alpha;
#pragma unroll
      for (int r = 0; r < 16; ++r) { o[0][r] *= alpha; o[1][r] *= alpha; }
    }
    float ps = 0.f;
#pragma unroll
    for (int r = 0; r < 16; ++r) {
      s0[r] = __builtin_amdgcn_exp2f(s0[r] - m); s1[r] = __builtin_amdgcn_exp2f(s1[r] - m); s2[r] = __builtin_amdgcn_exp2f(s2[r] - m); s3[r] = __builtin_amdgcn_exp2f(s3[r] - m);
      ps += (s0[r] + s1[r]) + (s2[r] + s3[r]);
    }
    lsum += ps;
    const lds_cptr vb0 = (lds_cptr)(lds + 36864 + buf * 16384) + vlane;
    const lds_cptr vb1 = vb0 + 8192;
    { const bf16x8 pa = ATT_PACK(s0, 0), pb = ATT_PACK(s1, 0), pc = ATT_PACK(s0, 1), pd = ATT_PACK(s1, 1);
      ATT_PV1(vb0, 0, pa); ATT_PV1(vb0, 32, pb); ATT_PV1(vb0, 16, pc); ATT_PV1(vb0, 48, pd); }
    { const bf16x8 pa = ATT_PACK(s2, 0), pb = ATT_PACK(s3, 0), pc = ATT_PACK(s2, 1), pd = ATT_PACK(s3, 1);
      ATT_PV1(vb1, 0, pa); ATT_PV1(vb1, 32, pb); ATT_PV1(vb1, 16, pc); ATT_PV1(vb1, 48, pd); }
    if (i + 1 < NI) ATT_LWRITE(buf ^ 1);
    __syncthreads();
  }
#undef ATT_GLOAD
#undef ATT_LWRITE
#undef ATT_MASK
#undef ATT_PACK
#undef ATT_PV1
  float lt = lsum + __shfl_xor(lsum, 32);
  float inv;
  if (has_sink) { const float sk = sink * 1.4426950408889634f; const float mf = fmaxf(m, sk); const float sc = __builtin_amdgcn_exp2f(m - mf); inv = sc / (lt * sc + __builtin_amdgcn_exp2f(sk - mf)); }
  else inv = 1.f / lt;
  u16* Op = Qp + (size_t)(wid * 32 + r32) * LDP;
  const u16* Gq = Gp + (size_t)(wid * 32 + r32) * LDP;
  uint2 gg[2][4];
#pragma unroll
  for (int db = 0; db < 2; ++db)
#pragma unroll
    for (int rq = 0; rq < 4; ++rq) gg[db][rq] = *(const uint2*)(Gq + db * 32 + 8 * rq + 4 * hi);
#pragma unroll
  for (int db = 0; db < 2; ++db)
#pragma unroll
    for (int rq = 0; rq < 4; ++rq) {
      const int d = db * 32 + 8 * rq + 4 * hi;
      const uint2 g = gg[db][rq];
      const float v0 = o[db][rq * 4 + 0] * inv * bflo(g.x), v1 = o[db][rq * 4 + 1] * inv * bfhi(g.x);
      const float v2 = o[db][rq * 4 + 2] * inv * bflo(g.y), v3 = o[db][rq * 4 + 3] * inv * bfhi(g.y);
      *(uint2*)(Op + d) = make_uint2(cvtpk(v0, v1), cvtpk(v2, v3));
    }
}

__device__ __forceinline__ void sgu_chunk(const Params& p, int l, int chunk, char* lds, int tid_in) {
  int tid = tid_in; asm volatile("" : "+v"(tid));
  const int lane = tid & 63, wid = tid >> 6, r32 = lane & 31, hi = lane >> 5;
  const int wc = wid >> 2, wp = wid & 3;
  const int R0 = chunk * 128;
  u16* Pr = p.P + (size_t)R0 * LDP;
  float* stt = (float*)(lds + 67584);
#pragma unroll
  for (int half = 0; half < 2; ++half) {
    uint4 raw[8];
#pragma unroll
    for (int rr = 0; rr < 8; ++rr) raw[rr] = *(const uint4*)(Pr + (size_t)(wid * 16 + half * 8 + rr) * LDP + 3072 + lane * 8);
#pragma unroll
    for (int rr = 0; rr < 8; ++rr) {
      const int row = wid * 16 + half * 8 + rr;
      const float x0 = bflo(raw[rr].x), x1 = bfhi(raw[rr].x), x2 = bflo(raw[rr].y), x3 = bfhi(raw[rr].y), x4 = bflo(raw[rr].z), x5 = bfhi(raw[rr].z), x6 = bflo(raw[rr].w), x7 = bfhi(raw[rr].w);
      const float mean = wave_sum(((x0 + x1) + (x2 + x3)) + ((x4 + x5) + (x6 + x7))) * (1.f / 512.f);
      const float d0 = x0 - mean, d1 = x1 - mean, d2 = x2 - mean, d3 = x3 - mean, d4 = x4 - mean, d5 = x5 - mean, d6 = x6 - mean, d7 = x7 - mean;
      const float rstd = rsqrtf(wave_sum(((d0 * d0 + d1 * d1) + (d2 * d2 + d3 * d3)) + ((d4 * d4 + d5 * d5) + (d6 * d6 + d7 * d7))) * (1.f / 512.f) + LN_EPS);
      if (lane == 0) { stt[row * 2] = mean; stt[row * 2 + 1] = rstd; }
    }
  }
  __syncthreads();
  const int ch = tid & 15, row0 = tid >> 4;
  uint4 wr0, wr1, wr2, wr3, vr0, vr1, vr2, vr3; f32x4 g0, g1, b0, b1;
#define SGU_GL1(i_, w_, v_, Wg_, g_) do { w_ = *(const uint4*)((Wg_) + (row0 + 32 * (i_)) * 128 + ch * 8); \
      v_ = *(const uint4*)(Pr + (size_t)(row0 + 32 * (i_)) * LDP + 3072 + (g_) * 128 + ch * 8); } while (0)
#define SGU_GLOAD(g_) do { const u16* Wg_ = p.wsp + (size_t)(l * 4 + (g_)) * 128 * 128; \
    SGU_GL1(0, wr0, vr0, Wg_, g_); SGU_GL1(1, wr1, vr1, Wg_, g_); SGU_GL1(2, wr2, vr2, Wg_, g_); SGU_GL1(3, wr3, vr3, Wg_, g_); \
    const float* gm_ = p.sgu_g + l * 512 + (g_) * 128 + ch * 8; const float* bt_ = p.sgu_b + l * 512 + (g_) * 128 + ch * 8; \
    g0 = *(const f32x4*)gm_; g1 = *(const f32x4*)(gm_ + 4); b0 = *(const f32x4*)bt_; b1 = *(const f32x4*)(bt_ + 4); } while (0)
#define SGU_LW1(i_, w_, v_) do { const int row = row0 + 32 * (i_); \
      *(uint4*)(lds + row * 272 + ch * 16) = w_; \
      const uint4 raw = v_; const float mean = stt[row * 2], rstd = stt[row * 2 + 1]; \
      const float y0 = (bflo(raw.x) - mean) * rstd * g0[0] + b0[0], y1 = (bfhi(raw.x) - mean) * rstd * g0[1] + b0[1]; \
      const float y2 = (bflo(raw.y) - mean) * rstd * g0[2] + b0[2], y3 = (bfhi(raw.y) - mean) * rstd * g0[3] + b0[3]; \
      const float y4 = (bflo(raw.z) - mean) * rstd * g1[0] + b1[0], y5 = (bfhi(raw.z) - mean) * rstd * g1[1] + b1[1]; \
      const float y6 = (bflo(raw.w) - mean) * rstd * g1[2] + b1[2], y7 = (bfhi(raw.w) - mean) * rstd * g1[3] + b1[3]; \
      *(uint4*)(lds + 34816 + (ch >> 2) * 8192 + row * 64 + (ch & 3) * 16) = make_uint4(cvtpk(y0, y1), cvtpk(y2, y3), cvtpk(y4, y5), cvtpk(y6, y7)); } while (0)
#define SGU_LWRITE() do { SGU_LW1(0, wr0, vr0); SGU_LW1(1, wr1, vr1); SGU_LW1(2, wr2, vr2); SGU_LW1(3, wr3, vr3); } while (0)
  SGU_GLOAD(0); SGU_LWRITE();
  __syncthreads();
  const lds_cptr vnb = (lds_cptr)(lds + 34816) + ((lane >> 4) & 1) * 32 + (lane & 3) * 8 + (8 * hi + ((lane & 15) >> 2)) * 64;
  const char* wb = lds + (wp * 32 + r32) * 272 + hi * 16;
  const int prow = wp * 32 + r32;
  u16* rowp = Pr + (size_t)prow * LDP;
#pragma unroll
  for (int g = 0; g < 4; ++g) {
    const int cg0 = g * 128;
    if (g < 3) SGU_GLOAD(g + 1);
    const float bs = p.b_spatial[(l * 4 + g) * 128 + prow];
    uint2 uu[2][4], gq[2][4];
#pragma unroll
    for (int ci = 0; ci < 2; ++ci)
#pragma unroll
      for (int rq = 0; rq < 4; ++rq) { const int c = cg0 + wc * 64 + ci * 32 + 8 * rq + 4 * hi; uu[ci][rq] = *(const uint2*)(rowp + 2560 + c); gq[ci][rq] = *(const uint2*)(rowp + 3584 + c); }
    f32x16 acc[2];
#pragma unroll
    for (int r = 0; r < 16; ++r) { acc[0][r] = 0.f; acc[1][r] = 0.f; }
#pragma unroll
    for (int ks = 0; ks < 8; ++ks) {
      const bf16x8 bfr = *(const bf16x8*)(wb + ks * 32);
#pragma unroll
      for (int ci = 0; ci < 2; ++ci) {
        const lds_cptr vp = vnb + (wc * 2 + ci) * 8192 + ks * 16 * 64;
        const s16x4 lo = vtr(vp), hh = vtr(vp + 256);
        const bf16x8 af = (bf16x8){lo[0], lo[1], lo[2], lo[3], hh[0], hh[1], hh[2], hh[3]};
        acc[ci] = MFMA(af, bfr, acc[ci]);
      }
    }
#pragma unroll
    for (int ci = 0; ci < 2; ++ci)
#pragma unroll
      for (int rq = 0; rq < 4; ++rq) {
        const int c = cg0 + wc * 64 + ci * 32 + 8 * rq + 4 * hi;
        const uint2 u = uu[ci][rq], gg = gq[ci][rq];
        const float v0 = bflo(u.x) * (acc[ci][rq * 4 + 0] + bs) * bflo(gg.x), v1 = bfhi(u.x) * (acc[ci][rq * 4 + 1] + bs) * bfhi(gg.x);
        const float v2 = bflo(u.y) * (acc[ci][rq * 4 + 2] + bs) * bflo(gg.y), v3 = bfhi(u.y) * (acc[ci][rq * 4 + 3] + bs) * bfhi(gg.y);
        *(uint2*)(rowp + 2560 + c) = make_uint2(cvtpk(v0, v1), cvtpk(v2, v3));
      }
    if (g < 3) {
      __syncthreads();
      SGU_LWRITE();
      __syncthreads();
    }
  }
#undef SGU_GL1
#undef SGU_GLOAD
#undef SGU_LW1
#undef SGU_LWRITE
}

__device__ __forceinline__ void phase_p3(const Params& p, int l, char* lds, int wv) {
  const int tid = opaque_tid(wv);
  volatile int* slot = (volatile int*)(lds + LDS_ITEM);
  while (true) {
    __syncthreads();
    if (tid == 0) *slot = atomicAdd(&p.cnt[l], 1);
    __syncthreads();
    const int item0 = *slot;
    if (item0 >= 288 + 864) break;
    if (item0 >= 128 && item0 < 416) {
      SchedGate S{(const char*)p.wt_ig, (const char*)p.H, item0 - 128};
      EpiGate E{p.b_gate, p.G, l};
      int tid2 = tid; asm volatile("" : "+v"(tid2));
      gemm_phase((LAS unsigned char*)lds, 1024, 1024, 1024, S, E, tid2);
      continue;
    }
    const int item = item0 < 128 ? item0 : item0 - 288;
    if (item >= 256 && item < 352) {
      sgu_chunk(p, l, item - 256, lds, tid);
    } else {
      u16* Qp; const u16 *Gp, *K0, *V0, *K1, *V1; int n0, n1, kpos0 = 0, qpos0 = 0; bool masked = false, has_sink = false; float sink = 0.f;
      if (item < 256) {
        const bool isB = item >= 128; const int it = item & 127;
        const int b = it >> 6, head = (it >> 3) & 7, qb = it & 7, kv = head >> 2;
        u16* base = p.P + (size_t)(NCTX + b * 2048) * LDP;
        const size_t coff = ((size_t)(b * 4 + l) * 512) * 128 + kv * 64;
        n1 = 512;
        if (!isB) {
          Qp = base + (size_t)qb * 256 * LDP + head * 64; Gp = base + (size_t)qb * 256 * LDP + 768 + head * 64;
          K0 = base + 512 + kv * 64; V0 = base + 640 + kv * 64; n0 = 2048;
          K1 = p.cachebf + coff; V1 = p.cachebf + 524288 + coff;
        } else {
          const int ks = qb * 256 - 128 < 0 ? 0 : qb * 256 - 128;
          const int ke = qb * 256 + 384 > 2048 ? 2048 : qb * 256 + 384;
          Qp = base + (size_t)qb * 256 * LDP + 1280 + head * 64; Gp = base + (size_t)qb * 256 * LDP + 2048 + head * 64;
          K0 = base + (size_t)ks * LDP + 1792 + kv * 64; V0 = base + (size_t)ks * LDP + 1920 + kv * 64; n0 = ke - ks;
          masked = true; kpos0 = ks; qpos0 = qb * 256;
          K1 = p.cachebf + 2 * 524288 + coff; V1 = p.cachebf + 3 * 524288 + coff;
          has_sink = true; sink = p.sink[l * 8 + head];
        }
      } else {
        const int it0 = item - 352; const bool isB = it0 >= 256; const int it = it0 & 255;
        const int b = it >> 3, head = it & 7, kv = head >> 2;
        u16* base = p.P + (size_t)(b * 256) * LDP;
        n0 = 256; n1 = 0; K1 = base; V1 = base;
        if (!isB) {
          Qp = base + head * 64; Gp = base + 768 + head * 64;
          K0 = base + 512 + kv * 64; V0 = base + 640 + kv * 64;
        } else {
          Qp = base + 1280 + head * 64; Gp = base + 2048 + head * 64;
          K0 = base + 1792 + kv * 64; V0 = base + 1920 + kv * 64;
          has_sink = true; sink = p.sink[l * 8 + head];
        }
      }
      attn_item(Qp, Gp, K0, V0, LDP, n0, masked, kpos0, qpos0, K1, V1, n1 ? 128 : LDP, n1, has_sink, sink, lds, tid);
    }
  }
  __syncthreads();
}

__device__ __forceinline__ void phase_p2(const Params& p, int l, char* lds, int wv) {
  const int tid = opaque_tid(wv);
  SchedP2 S{(const char*)p.wt_ig, (const char*)p.H, (int)gridDim.x, block_id()};
  EpiP2 E{p.b_gate, p.q_norm, p.k_norm, p.rope, p.out + (size_t)NTOK * 1024, p.P, p.G, l};
  gemm_phase((LAS unsigned char*)lds, 1024, 1024, 1024, S, E, tid);
  __syncthreads();
}
__device__ __forceinline__ void phase_p4(const Params& p, int l, char* lds, int wv) {
  const int tid = opaque_tid(wv);
  SchedP4 S{(const char*)p.wt_p, (const char*)p.P, block_id()};
  EpiP4 E{p.G, p.H};
  gemm_phase((LAS unsigned char*)lds, 512, 512, LDP, S, E, tid);
  __syncthreads();
}
__device__ __forceinline__ void phase_p5(const Params& p, int l, char* lds, int wv) {
  const int tid = opaque_tid(wv);
  SchedP5 S{(const char*)p.wt_o, (const char*)p.H, block_id()};
  EpiP5 E{p.mod, p.x_prompt, p.x_sample, p.out, l};
  gemm_phase((LAS unsigned char*)lds, 1024, 1024, 1024, S, E, tid);
  __syncthreads();
}

__device__ __forceinline__ Params load_params() {
#if defined(__HIP_DEVICE_COMPILE__)
  const __attribute__((address_space(4))) char* kp = (const __attribute__((address_space(4))) char*)__builtin_amdgcn_kernarg_segment_ptr();
  asm volatile("" : "+s"(kp));
  return *(const __attribute__((address_space(4))) Params*)kp;
#else
  return Params{};
#endif
}
__device__ __forceinline__ void run_phase(int ph, char* lds, int wv) {
  const Params p = load_params();
  if (ph == 0) { phase_pre(p, lds, wv); return; }
  const int k = ph + 3, l = k / 5 - 1, s = k - (l + 1) * 5;
  if (s == 0) phase_p2(p, l, lds, wv);
  else if (s == 1) phase_p3(p, l, lds, wv);
  else if (s == 2) phase_p4(p, l, lds, wv);
  else if (s == 3) phase_p5(p, l, lds, wv);
  else phase_row(p, l + 1, lds, wv);
}

__global__ void __launch_bounds__(512, 2) fwd_megakernel(Params p, int ph0, int ph1) {
  __shared__ __attribute__((aligned(16))) char lds[LDS_BYTES];
  if (ph1 < 0) cg::this_grid().sync();
  int wv;
  wv = __builtin_amdgcn_readfirstlane((int)(threadIdx.x >> 6));
  run_phase(0, lds, wv);
  hier_barrier(load_params().bar, 0u, wv);
  for (int ph = 1; ph < ph1; ++ph) {
    run_phase(ph, lds, wv);
    if (ph + 1 < ph1) hier_barrier(load_params().bar, (unsigned)ph, wv);
  }
}

extern "C" void kernel_launch(void* const* d_in, const int* in_sizes, int n_in, void* d_out, int out_size, void* d_ws, size_t ws_size, hipStream_t stream) {
  static int grid_blocks = 0;
  if (!grid_blocks) {
    int dev = 0, cus = 0, per_cu = 0;
    (void)hipGetDevice(&dev);
    (void)hipDeviceGetAttribute(&cus, hipDeviceAttributeMultiprocessorCount, dev);
    (void)hipOccupancyMaxActiveBlocksPerMultiprocessor(&per_cu, fwd_megakernel, NTHR, 0);
    if (per_cu < 1) fprintf(stderr, "occupancy query returned %d\n", per_cu);
    grid_blocks = cus;
  }
  Params p{};
  p.x_prompt = (const float*)d_in[0]; p.x_sample = (const float*)d_in[1];
  p.cache0 = (const float*)d_in[2]; p.cache1 = (const float*)d_in[3]; p.cache2 = (const float*)d_in[4]; p.cache3 = (const float*)d_in[5];
  p.c = (const float*)d_in[6]; p.c_ctx = (const float*)d_in[7];
  p.w_mod = (const float*)d_in[8]; p.b_mod = (const float*)d_in[9]; p.w_in = (const float*)d_in[10];
  p.q_norm = (const float*)d_in[11]; p.k_norm = (const float*)d_in[12]; p.sink = (const float*)d_in[13];
  p.sgu_g = (const float*)d_in[14]; p.sgu_b = (const float*)d_in[15]; p.w_spatial = (const float*)d_in[16]; p.b_spatial = (const float*)d_in[17];
  p.w_proj0 = (const float*)d_in[18]; p.w_proj1 = (const float*)d_in[19]; p.w_proj2 = (const float*)d_in[20];
  p.w_gate = (const float*)d_in[21]; p.b_gate = (const float*)d_in[22]; p.w_out = (const float*)d_in[23];
  p.ln_g = (const float*)d_in[24]; p.ln_b = (const float*)d_in[25];
  p.out = (float*)d_out;
  char* w = (char*)d_ws; size_t off = 0;
  auto take = [&](size_t bytes) { char* r = w + off; off += (bytes + 255) & ~(size_t)255; return r; };
  p.mod = (float*)take(4 * 3 * 3072 * 4);
  p.rope = (float*)take(2048 * 4);
  p.bar = (unsigned*)take(XCD_BAR_WORDS * 4);
  p.cnt = (int*)take(1024);
  p.wsp = (u16*)take(262144 * 2);
  p.cachebf = (u16*)take((size_t)4 * 524288 * 2);
  p.wt_ig = (u16*)take((size_t)7168 * 1024 * 2);
  p.wt_p = (u16*)take((size_t)3 * 1024 * 512 * 2);
  p.wt_o = (u16*)take((size_t)1024 * 1024 * 2);
  p.H = (u16*)take((size_t)NTOK * 1024 * 2);
  p.P = (u16*)take((size_t)NTOK * LDP * 2);
  p.G = (u16*)take((size_t)NTOK * 3072 * 2);
  if (off > ws_size) { fprintf(stderr, "workspace too small: need %zu have %zu\n", off, ws_size); return; }
  (void)hipMemsetAsync(p.bar, 0, XCD_BAR_WORDS * 4 + 1024, stream);
  int ph0 = 0, ph1 = 22;
  void* args[] = {&p, &ph0, &ph1};
  hipError_t e = hipLaunchCooperativeKernel((void*)fwd_megakernel, dim3(grid_blocks), dim3(NTHR), args, 0, stream);
  if (e != hipSuccess) fprintf(stderr, "cooperative launch failed: %s (grid %d)\n", hipGetErrorString(e), grid_blocks);
}
```
